# Optimizing an MI355X kernel written in HIP

```python
import jax, jax.numpy as jnp
from jax import lax
import numpy as np

D_MODEL = 2048
BATCH = 4
SEQ = 2048
DEPTH = 1
DEC_BATCH = 8
DEC_SEQ = 4
PAST_LEN = 16384
PAGE_SIZE = 128

SSD_HEADS = 16
SSD_HEADDIM = 64
SSD_INNER = SSD_HEADS * SSD_HEADDIM
SSD_GROUPS = 2
SSD_STATE = 128
CONV_W = 4
CONV_DIM = SSD_INNER + 2 * SSD_GROUPS * SSD_STATE
SSD_CHUNK = 128
ATT_HEADS = 16
ATT_KV_HEADS = 4
HEAD_DIM = 64
ATT_GQ = ATT_HEADS // ATT_KV_HEADS
ATT_INNER = ATT_HEADS * HEAD_DIM
ROT_DIM = HEAD_DIM // 4
ROPE_THETA = 500000.0
DILATED_BRANCHES = ((128, 1), (512, 4), (2048, 16))
W_MAX = 2048
Q_BLOCK = 128
D_MIX = SSD_INNER + ATT_INNER
EPS = 1e-6
IN_SPLITS = (SSD_INNER,
             SSD_INNER + CONV_DIM,
             SSD_INNER + CONV_DIM + SSD_HEADS,
             SSD_INNER + CONV_DIM + SSD_HEADS + ATT_INNER,
             SSD_INNER + CONV_DIM + SSD_HEADS + ATT_INNER + ATT_KV_HEADS * HEAD_DIM,
             SSD_INNER + CONV_DIM + SSD_HEADS + ATT_INNER + 2 * ATT_KV_HEADS * HEAD_DIM)
IN_COLS = SSD_INNER + CONV_DIM + SSD_HEADS + ATT_INNER + 2 * ATT_KV_HEADS * HEAD_DIM + ATT_INNER

kernel_name = "hymba_ssd_dilated_swa_step"


def rmsnorm(x, w):
    xf = x.astype(jnp.float32)
    y = xf * lax.rsqrt(jnp.mean(xf * xf, axis=-1, keepdims=True) + EPS)
    return y * w.astype(jnp.float32)


def rope_partial(x, pos):
    half = ROT_DIM // 2
    inv = ROPE_THETA ** (-jnp.arange(0, ROT_DIM, 2, dtype=jnp.float32) / ROT_DIM)
    ang = pos.astype(jnp.float32)[:, None] * inv[None, :]
    cos = jnp.cos(ang)[None, :, None, :]
    sin = jnp.sin(ang)[None, :, None, :]
    x1 = x[..., :half]
    x2 = x[..., half:ROT_DIM]
    return jnp.concatenate([x1 * cos - x2 * sin, x2 * cos + x1 * sin, x[..., ROT_DIM:]], axis=-1)


def causal_conv(xbc, conv_prev, conv_w, conv_b):
    T = xbc.shape[1]
    xp = jnp.concatenate([conv_prev.astype(xbc.dtype), xbc], axis=1)
    y = sum(conv_w[k] * xp[:, k:k + T] for k in range(CONV_W)) + conv_b
    return jax.nn.silu(y), xp[:, T:]


def ssd_chunked(x, dt, a, bm, cm, h0, chunk):
    Bsz, T, H, P = x.shape
    G, N = bm.shape[2], bm.shape[3]
    R = H // G
    nc = T // chunk
    x = x.reshape(Bsz, nc, chunk, G, R, P)
    dt = dt.reshape(Bsz, nc, chunk, G, R)
    bm = bm.reshape(Bsz, nc, chunk, G, N)
    cm = cm.reshape(Bsz, nc, chunk, G, N)
    cum = jnp.cumsum(dt * a.reshape(G, R), axis=2)
    causal = jnp.tril(jnp.ones((chunk, chunk), dtype=bool))[:, :, None, None]
    seg = cum[:, :, :, None] - cum[:, :, None, :]
    decay = jnp.exp(jnp.where(causal, seg, -jnp.inf))
    cb = jnp.einsum('bclgn,bcsgn->bclsg', cm, bm)
    scores = cb[..., None] * decay * dt[:, :, None]
    y_diag = jnp.einsum('bclsgr,bcsgrp->bclgrp', scores, x)
    decay_end = jnp.exp(cum[:, :, -1:] - cum)
    st = jnp.einsum('bcsgn,bcsgrp->bcgrpn', bm, x * (decay_end * dt)[..., None])
    chunk_decay = jnp.exp(cum[:, :, -1])

    def step(h, inp):
        s_c, d_c = inp
        return h * d_c[..., None, None] + s_c, h

    h_final, h_prev = lax.scan(step, h0.astype(jnp.float32).reshape(Bsz, G, R, P, N),
                               (jnp.moveaxis(st, 1, 0), jnp.moveaxis(chunk_decay, 1, 0)))
    h_prev = jnp.moveaxis(h_prev, 0, 1)
    y_off = jnp.einsum('bclgn,bcgrpn->bclgrp', cm, h_prev) * jnp.exp(cum)[..., None]
    y = (y_diag + y_off).reshape(Bsz, T, H, P)
    return y, h_final.reshape(Bsz, H, P, N)


def dilated_window_attention(q, k_ext, v_ext, q_idx, lo):
    nums, dens, maxs = [], [], []
    for window, dil in DILATED_BRANCHES:
        offs = jnp.arange(window // dil + 1, dtype=jnp.int32) * dil
        idx = q_idx[:, None] - offs[None, :]
        valid = idx >= lo
        idx = jnp.maximum(idx, 0)
        kg = jnp.take(k_ext, idx, axis=1)
        vg = jnp.take(v_ext, idx, axis=1)
        s = jnp.einsum('bqhgd,bqjhd->bqhgj', q, kg).astype(jnp.float32)
        s = jnp.where(valid[None, :, None, None, :], s, -jnp.inf)
        m = jnp.max(s, axis=-1)
        p = jnp.exp(s - m[..., None])
        maxs.append(m)
        dens.append(jnp.sum(p, axis=-1))
        nums.append(jnp.einsum('bqhgj,bqjhd->bqhgd', p, vg.astype(jnp.float32)))
    mx = jnp.max(jnp.stack(maxs), axis=0)
    ws = [jnp.exp(m - mx) for m in maxs]
    num = sum(n * w[..., None] for n, w in zip(nums, ws))
    den = sum(d * w for d, w in zip(dens, ws))
    return num / den[..., None]


def prompt_attention(q, k, v):
    B, T = q.shape[0], q.shape[1]
    k_pad = jnp.pad(k, ((0, 0), (W_MAX, 0), (0, 0), (0, 0)))
    v_pad = jnp.pad(v, ((0, 0), (W_MAX, 0), (0, 0), (0, 0)))
    nb = T // Q_BLOCK
    q_blocks = jnp.moveaxis(q.reshape(B, nb, Q_BLOCK, ATT_KV_HEADS, ATT_GQ, HEAD_DIM), 1, 0)
    starts = jnp.arange(nb, dtype=jnp.int32) * Q_BLOCK

    def one_block(args):
        q_blk, start = args
        q_idx = W_MAX + start + jnp.arange(Q_BLOCK, dtype=jnp.int32)
        return dilated_window_attention(q_blk, k_pad, v_pad, q_idx, W_MAX)

    o = lax.map(one_block, (q_blocks, starts))
    o = jnp.moveaxis(o, 0, 1).reshape(B, T, ATT_KV_HEADS, ATT_GQ, HEAD_DIM)
    keep = min(W_MAX, T)
    return o, k[:, T - keep:], v[:, T - keep:]


def sample_attention(q, k, v, cache_k, cache_v):
    win = cache_k.shape[1]
    Ts = q.shape[1]
    k_ext = jnp.concatenate([cache_k.astype(k.dtype), k], axis=1)
    v_ext = jnp.concatenate([cache_v.astype(v.dtype), v], axis=1)
    q_idx = win + jnp.arange(Ts, dtype=jnp.int32)
    o = dilated_window_attention(q, k_ext, v_ext, q_idx, 0)
    return o, k_ext[:, Ts:], v_ext[:, Ts:]


def hybrid_layer(x, pos, conv_prev, h0, ssd_chunk, attend, norm_w, w_in, conv_w, conv_b,
                 dt_bias, a_log, d_skip, ssd_norm_w, q_norm_w, k_norm_w, w_out):
    B, T, _ = x.shape
    hn = rmsnorm(x, norm_w)
    proj = hn @ w_in.astype(jnp.float32)
    z, xbc, dt_raw, q, k, v, gate = jnp.split(proj, IN_SPLITS, axis=-1)
    xbc_c, conv_new = causal_conv(xbc, conv_prev, conv_w, conv_b)
    xs, bm, cm = jnp.split(xbc_c, [SSD_INNER, SSD_INNER + SSD_GROUPS * SSD_STATE], axis=-1)
    dt = jax.nn.softplus(dt_raw + dt_bias)
    a = -jnp.exp(a_log.astype(jnp.float32))
    xh = xs.reshape(B, T, SSD_HEADS, SSD_HEADDIM)
    y_ssd, h_new = ssd_chunked(xh, dt, a, bm.reshape(B, T, SSD_GROUPS, SSD_STATE),
                               cm.reshape(B, T, SSD_GROUPS, SSD_STATE), h0, ssd_chunk)
    y_ssd = (y_ssd + d_skip[:, None] * xh).reshape(B, T, SSD_INNER) * jax.nn.silu(z)
    y_ssd = rmsnorm(y_ssd.reshape(B, T, SSD_GROUPS, SSD_INNER // SSD_GROUPS),
                    ssd_norm_w.reshape(SSD_GROUPS, SSD_INNER // SSD_GROUPS)).reshape(B, T, SSD_INNER)
    q = rope_partial(rmsnorm(q.reshape(B, T, ATT_HEADS, HEAD_DIM), q_norm_w), pos) * (HEAD_DIM ** -0.5)
    k = rope_partial(rmsnorm(k.reshape(B, T, ATT_KV_HEADS, HEAD_DIM), k_norm_w), pos)
    v = v.reshape(B, T, ATT_KV_HEADS, HEAD_DIM)
    o, k_state, v_state = attend(q.reshape(B, T, ATT_KV_HEADS, ATT_GQ, HEAD_DIM), k, v)
    y_att = o.reshape(B, T, ATT_INNER) * jax.nn.silu(gate)
    out = jnp.concatenate([y_ssd, y_att], axis=-1) @ w_out.astype(jnp.float32)
    return (x + out).astype(x.dtype), conv_new, h_new, k_state, v_state


def setup_inputs(seed: int = 0) -> dict:
    key = jax.random.key(seed)
    ks = jax.random.split(key, 20)
    win = min(W_MAX, PAST_LEN)
    f32 = jnp.float32
    dt0 = jnp.exp(jax.random.uniform(ks[10], (DEPTH, SSD_HEADS), f32)
                  * (np.log(0.1) - np.log(0.001)) + np.log(0.001))
    return {
        "x_prompt": jax.random.normal(ks[0], (BATCH, SEQ, D_MODEL), f32),
        "x_sample": jax.random.normal(ks[1], (DEC_BATCH, DEC_SEQ, D_MODEL), f32),
        "cache_k": jax.random.normal(ks[2], (DEPTH, DEC_BATCH, win, ATT_KV_HEADS, HEAD_DIM), f32),
        "cache_v": jax.random.normal(ks[3], (DEPTH, DEC_BATCH, win, ATT_KV_HEADS, HEAD_DIM), f32),
        "state_conv": jax.random.normal(ks[4], (DEPTH, DEC_BATCH, CONV_W - 1, CONV_DIM), f32),
        "state_ssm": 0.5 * jax.random.normal(ks[5], (DEPTH, DEC_BATCH, SSD_HEADS, SSD_HEADDIM, SSD_STATE), f32),
        "norm_w": 1.0 + 0.01 * jax.random.normal(ks[6], (DEPTH, D_MODEL), f32),
        "w_in": jax.random.normal(ks[7], (DEPTH, D_MODEL, IN_COLS), f32) * D_MODEL ** -0.5,
        "conv_w": jax.random.normal(ks[8], (DEPTH, CONV_W, CONV_DIM), f32) * CONV_W ** -0.5,
        "conv_b": 0.01 * jax.random.normal(ks[9], (DEPTH, CONV_DIM), f32),
        "dt_bias": dt0 + jnp.log(-jnp.expm1(-dt0)),
        "a_log": jnp.log(jax.random.uniform(ks[11], (DEPTH, SSD_HEADS), f32, 1.0, 16.0)),
        "d_skip": 1.0 + 0.1 * jax.random.normal(ks[12], (DEPTH, SSD_HEADS), f32),
        "ssd_norm_w": 1.0 + 0.01 * jax.random.normal(ks[13], (DEPTH, SSD_INNER), f32),
        "q_norm_w": 1.0 + 0.01 * jax.random.normal(ks[14], (DEPTH, HEAD_DIM), f32),
        "k_norm_w": 1.0 + 0.01 * jax.random.normal(ks[15], (DEPTH, HEAD_DIM), f32),
        "w_out": jax.random.normal(ks[16], (DEPTH, D_MIX, D_MODEL), f32) * D_MIX ** -0.5,
    }


def reference(x_prompt, x_sample, cache_k, cache_v, state_conv, state_ssm, norm_w, w_in, conv_w,
              conv_b, dt_bias, a_log, d_skip, ssd_norm_w, q_norm_w, k_norm_w, w_out):
    Bp, Tp = x_prompt.shape[0], x_prompt.shape[1]
    Bs, Ts = x_sample.shape[0], x_sample.shape[1]
    pos_p = jnp.arange(Tp, dtype=jnp.int32)
    pos_s = PAST_LEN + jnp.arange(Ts, dtype=jnp.int32)
    yp, ys = x_prompt, x_sample
    kp, vp, cp, hp, kss, vss, css, hss = [], [], [], [], [], [], [], []
    for l in range(DEPTH):
        weights = (norm_w[l], w_in[l], conv_w[l], conv_b[l], dt_bias[l], a_log[l], d_skip[l],
                   ssd_norm_w[l], q_norm_w[l], k_norm_w[l], w_out[l])
        yp, c_new, h_new, k_new, v_new = hybrid_layer(
            yp, pos_p, jnp.zeros((Bp, CONV_W - 1, CONV_DIM), jnp.float32),
            jnp.zeros((Bp, SSD_HEADS, SSD_HEADDIM, SSD_STATE), jnp.float32),
            min(SSD_CHUNK, Tp), prompt_attention, *weights)
        kp.append(k_new); vp.append(v_new); cp.append(c_new); hp.append(h_new)
        ck, cv = cache_k[l], cache_v[l]
        ys, c_new, h_new, k_new, v_new = hybrid_layer(
            ys, pos_s, state_conv[l], state_ssm[l], Ts,
            lambda q, k, v: sample_attention(q, k, v, ck, cv), *weights)
        kss.append(k_new); vss.append(v_new); css.append(c_new); hss.append(h_new)
    return (yp, ys, jnp.stack(kp), jnp.stack(vp), jnp.stack(cp), jnp.stack(hp),
            jnp.stack(kss), jnp.stack(vss), jnp.stack(css), jnp.stack(hss))
```

```cpp
#include <hip/hip_runtime.h>
#include <hip/hip_cooperative_groups.h>
#include <cstdio>
#include <cstdint>
namespace cg = cooperative_groups;
#ifndef N_LAUNCHES
#define N_LAUNCHES 1
#endif
namespace pg8 {
#define PG8_LAS __attribute__((address_space(3)))
typedef unsigned short bf16_t;
typedef short bf16x8 __attribute__((ext_vector_type(8)));
typedef float f32x4 __attribute__((ext_vector_type(4)));
typedef unsigned u32x4 __attribute__((ext_vector_type(4)));
constexpr int BM = 256, BK = 64, HALF = 128, HTB = HALF * BK * 2  , STAGE_BYTES = 8 * HTB, NXCD = 8, WGM = 8;

__host__ __device__ __forceinline__ int lds_byte(int r, int c) { const int st = (r >> 4) * 2 + (c >> 5), rr = r & 15, cc = c & 31, ob = rr * 64 + cc * 2; return st * 1024 + (ob ^ (((ob >> 9) & 1) << 5)); }
__host__ __device__ __forceinline__ void stage_rc(int b, int& R, int& C) { const int st = b / 1024, sb = b % 1024, swz = sb ^ (((sb >> 9) & 1) << 5); R = (st >> 1) * 16 + swz / 64; C = (st & 1) * 32 + (swz % 64) / 2; }
__host__ __device__ __forceinline__ int perm32(int rho) { const int n = rho >> 4, i = rho & 15; return 8 * (i >> 2) + 4 * n + (i & 3); }

struct Unit { int pm, pn; };
struct Gemm { const bf16_t* A; const bf16_t* Bt; int M, N, K; };

struct StaticOrder {
    int nM, nN, nwg, G, c;
    __host__ __device__ void init(int M, int N, int G_, int c_) { nM = M / BM; nN = N / BM; nwg = nM * nN; G = G_; c = c_; }
    __host__ __device__ bool next(int i, Unit& u) const {
        const long L = (long)i * G + c; if (L >= nwg) return false;
        int wgid = (int)L; { const int q = nwg / NXCD, r = nwg % NXCD, xcd = wgid % NXCD, off = wgid / NXCD; wgid = (xcd < r ? xcd * (q + 1) : r * (q + 1) + (xcd - r) * q) + off; }
        const int nig = WGM * nN, gid = wgid / nig, fm = gid * WGM, gsz = (nM - fm) < WGM ? (nM - fm) : WGM;
        u.pm = fm + ((wgid % nig) % gsz); u.pn = (wgid % nig) / gsz; return true;
    }
    __device__ __forceinline__ void a_ready(const Unit&) const {}
    __device__ __forceinline__ void done(const Unit&) const {}
};
__device__ __forceinline__ unsigned cvt_pk_bf16(float lo, float hi) { unsigned r; asm volatile("v_cvt_pk_bf16_f32 %0, %1, %2" : "=v"(r) : "v"(lo), "v"(hi)); return r; }
typedef float f32x2 __attribute__((ext_vector_type(2)));
template <class Epi, class Sched, bool ALIGN_EPI = false, bool SP2 = false>
__device__ __forceinline__ void gemm_phase(PG8_LAS unsigned char* lds, const Gemm g, const Sched& S, const Epi& E) {
    const int tid = threadIdx.x, wid = __builtin_amdgcn_readfirstlane(tid >> 6), lane = tid & 63, wr = wid >> 2, wc = wid & 3, fr = lane & 15, fq = lane >> 4;
    const int K = g.K, nt = K / BK;
    unsigned voffA[2], voffB[2];
#pragma unroll
    for (int i = 0; i < 2; ++i) { int R, C; stage_rc(tid * 16 + i * 8192, R, C); const int Rb = Epi::PERM ? ((R & ~31) + perm32(R & 31)) : R;
        voffA[i] = (unsigned)(R * K + C) * 2u; voffB[i] = (unsigned)(Rb * K + C) * 2u; }
    const size_t kstep = (size_t)(BK * 2);
    const size_t hstep = (size_t)HALF * K * 2;
    const size_t tstep = 2 * hstep;
    const unsigned ldsw = (unsigned)wid * 1024u;
    const int aoff = lds_byte(wr * 64 + fr, fq * 8), boff = lds_byte(wc * 32 + fr, fq * 8);
#define PG8_SA(b, h) (((b) * 2 + (h)) * HTB)
#define PG8_SB(b, h) ((4 + (b) * 2 + (h)) * HTB)
#define PG8_STAGE(bufoff, gbase, voff) do { _Pragma("unroll") for (int _i = 0; _i < 2; ++_i) \
        __builtin_amdgcn_global_load_lds((const unsigned*)((const char*)(gbase) + (voff)[_i]), (PG8_LAS unsigned*)(lds + (bufoff) + ldsw + _i * 8192), 16, 0, 0); } while (0)
#define PG8_LDA(dst, b, h) do { _Pragma("unroll") for (int m = 0; m < 4; ++m) _Pragma("unroll") for (int k = 0; k < 2; ++k) dst[m][k] = *(const PG8_LAS bf16x8*)(lds + PG8_SA(b, h) + aoff + m * 2048 + k * 1024); } while (0)
#define PG8_LDB(dst, b, h) do { _Pragma("unroll") for (int n = 0; n < 2; ++n) _Pragma("unroll") for (int k = 0; k < 2; ++k) dst[n][k] = *(const PG8_LAS bf16x8*)(lds + PG8_SB(b, h) + boff + n * 2048 + k * 1024); } while (0)
#define PG8_MMA(ai, bj, At, Bt) do { __builtin_amdgcn_s_setprio(1); _Pragma("unroll") for (int m = 0; m < 4; ++m) _Pragma("unroll") for (int n = 0; n < 2; ++n) _Pragma("unroll") for (int k = 0; k < 2; ++k) \
        acc[ai][bj][m][n] = __builtin_amdgcn_mfma_f32_16x16x32_bf16(Bt[n][k], At[m][k], acc[ai][bj][m][n], 0, 0, 0); __builtin_amdgcn_s_setprio(0); } while (0)
#define PG8_WAIT_V(n) asm volatile("s_waitcnt vmcnt(" #n ")" ::: "memory")
#define PG8_WAIT_L(n) asm volatile("s_waitcnt lgkmcnt(" #n ")" ::: "memory")
#define PG8_BAR __builtin_amdgcn_s_barrier()
#define PG8_SCHED __builtin_amdgcn_sched_barrier(0)
    Unit cur, nxt; int ui = 0;
    if (!S.next(0, cur)) return;
    f32x4 acc[2][2][4][2];
#pragma unroll
    for (int a = 0; a < 2; ++a)
#pragma unroll
        for (int b = 0; b < 2; ++b)
#pragma unroll
            for (int m = 0; m < 4; ++m)
#pragma unroll
                for (int n = 0; n < 2; ++n) acc[a][b][m][n] = (f32x4){0.f, 0.f, 0.f, 0.f};
    bf16x8 At[4][2], B0[2][2], B1[2][2];
    const char* cA = (const char*)g.A + (size_t)cur.pm * tstep; const char* cB = (const char*)g.Bt + (size_t)cur.pn * tstep;
    S.a_ready(cur);
    if constexpr (SP2) {
        PG8_STAGE(PG8_SB(0, 0), cB, voffB); PG8_STAGE(PG8_SB(0, 1), cB + hstep, voffB); PG8_STAGE(PG8_SA(0, 0), cA, voffA); PG8_STAGE(PG8_SA(0, 1), cA + hstep, voffA);
        if (wr == 1) PG8_BAR;
        PG8_WAIT_V(2); PG8_BAR;
        PG8_STAGE(PG8_SB(1, 0), cB + kstep, voffB); PG8_STAGE(PG8_SA(1, 0), cA + kstep, voffA); PG8_STAGE(PG8_SB(1, 1), cB + hstep + kstep, voffB);
        PG8_WAIT_V(6); PG8_BAR;
    } else {
        PG8_STAGE(PG8_SB(0, 0), cB, voffB); PG8_STAGE(PG8_SA(0, 0), cA, voffA); PG8_STAGE(PG8_SB(0, 1), cB + hstep, voffB); PG8_STAGE(PG8_SA(0, 1), cA + hstep, voffA);
        if (wr == 1) PG8_BAR;
        PG8_WAIT_V(4); PG8_BAR;
        PG8_STAGE(PG8_SB(1, 0), cB + kstep, voffB); PG8_STAGE(PG8_SA(1, 0), cA + kstep, voffA); PG8_STAGE(PG8_SB(1, 1), cB + hstep + kstep, voffB);
        PG8_WAIT_V(6); PG8_BAR;
    }
    for (;;) {
        const bool has_next = S.next(ui + 1, nxt);
        const char* nA = has_next ? (const char*)g.A + (size_t)nxt.pm * tstep : cA; const char* nB = has_next ? (const char*)g.Bt + (size_t)nxt.pn * tstep : cB;
        for (int t = 0; t < nt; t += 2) {
            if constexpr (Epi::RESCALE) { if (t == 8 || t == 16) E.rescale(acc, t, wr, fr, lds); }
            const bool last = (t == nt - 2);
            const char* a1 = cA + (size_t)(t + 1) * kstep;
            const char* a2 = last ? nA : cA + (size_t)(t + 2) * kstep; const char* b2 = last ? nB : cB + (size_t)(t + 2) * kstep;
            const char* a3 = a2 + kstep; const char* b3 = b2 + kstep;
            if (last && has_next) S.a_ready(nxt);
            if constexpr (SP2) {
            PG8_LDB(B0, 0, 0); PG8_LDB(B1, 0, 1); PG8_SCHED; PG8_LDA(At, 0, 0); PG8_STAGE(PG8_SA(1, 1), a1 + hstep, voffA);
            PG8_WAIT_V(8); PG8_WAIT_L(0); PG8_BAR; PG8_MMA(0, 0, At, B0); PG8_MMA(0, 1, At, B1); PG8_BAR; PG8_SCHED;
            PG8_LDA(At, 0, 1); PG8_STAGE(PG8_SB(0, 0), b2, voffB); PG8_STAGE(PG8_SB(0, 1), b2 + hstep, voffB); PG8_STAGE(PG8_SA(0, 0), a2, voffA);
            PG8_WAIT_V(8); PG8_WAIT_L(0); PG8_BAR; PG8_MMA(1, 0, At, B0); PG8_MMA(1, 1, At, B1); PG8_BAR; PG8_SCHED;
            PG8_LDB(B0, 1, 0); PG8_LDB(B1, 1, 1); PG8_SCHED; PG8_LDA(At, 1, 0); PG8_STAGE(PG8_SA(0, 1), a2 + hstep, voffA);
            PG8_WAIT_V(8); PG8_WAIT_L(0); PG8_BAR; PG8_MMA(0, 0, At, B0); PG8_MMA(0, 1, At, B1); PG8_BAR; PG8_SCHED;
            PG8_LDA(At, 1, 1); PG8_STAGE(PG8_SB(1, 0), b3, voffB); PG8_STAGE(PG8_SB(1, 1), b3 + hstep, voffB); PG8_STAGE(PG8_SA(1, 0), a3, voffA);
            PG8_WAIT_V(8); PG8_WAIT_L(0); PG8_BAR; PG8_MMA(1, 0, At, B0); PG8_MMA(1, 1, At, B1); PG8_BAR; PG8_SCHED;
            } else {
            PG8_LDB(B0, 0, 0); PG8_SCHED; PG8_LDA(At, 0, 0); PG8_STAGE(PG8_SA(1, 1), a1 + hstep, voffA);
            PG8_WAIT_L(8); PG8_BAR; PG8_WAIT_L(0); PG8_MMA(0, 0, At, B0); PG8_BAR; PG8_SCHED;
            PG8_LDB(B1, 0, 1); PG8_STAGE(PG8_SB(0, 0), b2, voffB);
            PG8_BAR; PG8_WAIT_L(0); PG8_MMA(0, 1, At, B1); PG8_BAR;
            PG8_LDA(At, 0, 1); PG8_STAGE(PG8_SA(0, 0), a2, voffA);
            PG8_BAR; PG8_WAIT_L(0); PG8_MMA(1, 0, At, B0); PG8_BAR; PG8_SCHED;
            PG8_STAGE(PG8_SB(0, 1), b2 + hstep, voffB);
            PG8_WAIT_V(6); PG8_BAR; PG8_MMA(1, 1, At, B1); PG8_BAR;
            PG8_LDB(B0, 1, 0); PG8_SCHED; PG8_LDA(At, 1, 0); PG8_STAGE(PG8_SA(0, 1), a2 + hstep, voffA);
            PG8_WAIT_L(8); PG8_BAR; PG8_WAIT_L(0); PG8_MMA(0, 0, At, B0); PG8_BAR; PG8_SCHED;
            PG8_LDB(B1, 1, 1); PG8_STAGE(PG8_SB(1, 0), b3, voffB);
            PG8_BAR; PG8_WAIT_L(0); PG8_MMA(0, 1, At, B1); PG8_BAR;
            PG8_LDA(At, 1, 1); PG8_STAGE(PG8_SA(1, 0), a3, voffA);
            PG8_BAR; PG8_WAIT_L(0); PG8_MMA(1, 0, At, B0); PG8_BAR; PG8_SCHED;
            PG8_STAGE(PG8_SB(1, 1), b3 + hstep, voffB);
            PG8_WAIT_V(6); PG8_BAR; PG8_MMA(1, 1, At, B1); PG8_BAR;
            }
        }
        if constexpr (ALIGN_EPI) { if (wr == 0) PG8_BAR; }
        if constexpr (!Epi::AFTER_DRAIN) { E(acc, cur, wr, wc, fr, fq); S.done(cur); }
        if (!has_next) break;
#pragma unroll
        for (int a = 0; a < 2; ++a)
#pragma unroll
            for (int b = 0; b < 2; ++b)
#pragma unroll
                for (int m = 0; m < 4; ++m)
#pragma unroll
                    for (int n = 0; n < 2; ++n) acc[a][b][m][n] = (f32x4){0.f, 0.f, 0.f, 0.f};
        cur = nxt; cA = nA; cB = nB; ++ui;
        if constexpr (ALIGN_EPI) { if (wr == 1) PG8_BAR; }
    }
    PG8_WAIT_V(0);
    if constexpr (!ALIGN_EPI) { if (wr == 0) PG8_BAR; }
    PG8_BAR;
    if constexpr (Epi::AFTER_DRAIN) { E.fused(acc, cur, wr, wc, fr, fq, lds, wid, lane); S.done(cur); }
#undef PG8_SA
#undef PG8_SB
#undef PG8_STAGE
#undef PG8_LDA
#undef PG8_LDB
#undef PG8_MMA
#undef PG8_WAIT_V
#undef PG8_WAIT_L
#undef PG8_BAR
#undef PG8_SCHED
}
}

using pg8::bf16_t; using pg8::bf16x8; using pg8::f32x4; using pg8::u32x4;
#define LAS __attribute__((address_space(3)))
constexpr int DM = 2048, TP = 2048, BP = 4, MP = BP * TP, BS = 8, TS = 4, MS = BS * TS;
constexpr int NCOL = 5136, NBIG = 5120;
constexpr int C_Z = 0, C_XBC = 1024, C_Q = 2560, C_K = 3584, C_V = 3840, C_G = 4096, C_DT = 5120;
constexpr int CONVD = 1536;
constexpr float EPS = 1e-6f;
constexpr float LOG2E = 1.4426950408889634f, QSCALE = 0.125f * LOG2E;
constexpr size_t WS_CTL = 0;
constexpr size_t WS_BAR = 16384;
constexpr size_t WS_CTL_BYTES = 32768;
constexpr size_t WS_WTIN = WS_CTL_BYTES;
constexpr size_t WS_WTOUT = WS_WTIN + (size_t)NCOL * DM * 2;
constexpr size_t WS_XN = WS_WTOUT + (size_t)DM * DM * 2;
constexpr size_t WS_PROJ = WS_XN + (size_t)(MP + MS) * DM * 2;
constexpr size_t WS_DT = WS_PROJ + (size_t)MP * NBIG * 2;
constexpr size_t WS_SPROJ = WS_DT + (size_t)MP * 16 * 4;
constexpr size_t WS_ROPE = WS_SPROJ + (size_t)MS * NCOL * 4;
constexpr size_t WS_YMIX = WS_ROPE + (size_t)(TP + TS) * 16 * 4;
constexpr size_t WS_SSQ = WS_YMIX + (size_t)(MP + MS) * DM * 2;
constexpr size_t WS_VT4 = WS_SSQ + (size_t)(MP + MS) * 16 * 4;
constexpr size_t WS_VT1 = WS_VT4 + (size_t)MP * 256 * 2;
constexpr size_t WS_VT16 = WS_VT1 + (size_t)MP * 256 * 2;
constexpr size_t WS_SPART = WS_VT16 + (size_t)MP * 256 * 2 + 4096;
constexpr size_t WS_ST = WS_SPART + (size_t)MS * 16 * 3 * 68 * 4;
constexpr size_t WS_XCC = WS_ST + (size_t)BP * 16 * 16 * 8192 * 4;
constexpr size_t WS_EL = WS_XCC + (size_t)MP * 256 * 2;
constexpr size_t WS_CD = WS_EL + (size_t)MP * 16 * 4;
constexpr size_t WS_END = WS_CD + 4096;
constexpr size_t WS_YD = WS_XN;
constexpr size_t O_YP = 0;
constexpr size_t O_YS = O_YP + (size_t)MP * DM;
constexpr size_t O_KP = O_YS + (size_t)MS * DM;
constexpr size_t O_VP = O_KP + (size_t)MP * 256;
constexpr size_t O_CP = O_VP + (size_t)MP * 256;
constexpr size_t O_HP = O_CP + (size_t)BP * 3 * CONVD;
constexpr size_t O_KS = O_HP + (size_t)BP * 16 * 64 * 128;
constexpr size_t O_VS = O_KS + (size_t)BS * 2048 * 256;
constexpr size_t O_CS = O_VS + (size_t)BS * 2048 * 256;
constexpr size_t O_HS = O_CS + (size_t)BS * 3 * CONVD;
constexpr size_t O_END = O_HS + (size_t)BS * 16 * 64 * 128;

constexpr int NT = 512, NW = 8;
constexpr int LDS_BYTES = 147456;

struct Ctx {
    const float *x_prompt, *x_sample, *cache_k, *cache_v, *state_conv, *state_ssm, *norm_w, *w_in, *conv_w, *conv_b, *dt_bias, *a_log, *d_skip, *ssd_norm_w, *q_norm_w, *k_norm_w, *w_out;
    float* out; unsigned* ctl;
    bf16_t *wt_in, *wt_out, *xn, *proj, *ymix, *vt1, *vt4, *vt16; float *dt, *sproj, *rope, *ssq, *spart, *st, *el, *cd, *yd; bf16_t* xcc;
};

__device__ __forceinline__ unsigned pk2(float lo, float hi) { return pg8::cvt_pk_bf16(lo, hi); }
__device__ __forceinline__ float bf_lo(unsigned u) { return __uint_as_float(u << 16); }
__device__ __forceinline__ float bf_hi(unsigned u) { return __uint_as_float(u & 0xffff0000u); }
__device__ __forceinline__ float bf2f(bf16_t h) { return __uint_as_float((unsigned)h << 16); }
__device__ __forceinline__ bf16_t f2bf(float f) { return (bf16_t)(pk2(f, 0.f) & 0xffffu); }
__device__ __forceinline__ float silu_f(float v) { return v * __builtin_amdgcn_rcpf(1.f + __expf(-v)); }
__device__ __forceinline__ float softplus_f(float v) { return v > 20.f ? v : log1pf(__expf(v)); }
__device__ __forceinline__ float wave_sum(float v) {
#pragma unroll
    for (int o = 32; o >= 1; o >>= 1) v += __shfl_xor(v, o);
    return v;
}
__device__ __forceinline__ float wave_max(float v) {
#pragma unroll
    for (int o = 32; o >= 1; o >>= 1) v = fmaxf(v, __shfl_xor(v, o));
    return v;
}
__device__ __forceinline__ int tileperm(int l) { const int wc = l >> 6, fq = (l >> 4) & 3, bj = (l >> 3) & 1, n = (l >> 2) & 1, e = l & 3; return 128 * bj + 32 * wc + 16 * n + 4 * fq + e; }
__device__ __forceinline__ int tileperm_inv(int p) { const int bj = p >> 7, wc = (p >> 5) & 3, n = (p >> 4) & 1, fq = (p >> 2) & 3, e = p & 3; return 64 * wc + 16 * fq + 8 * bj + 4 * n + e; }
__device__ __forceinline__ int logical_col_in(int s) { return s < 2560 ? s : (s < 2576 ? NBIG + (s - 2560) : s - 16); }
__device__ __forceinline__ int phys_row_of_logical(int c) { return c >= NBIG ? c : (c & ~255) + tileperm(c & 255); }
__device__ __forceinline__ int logical_of_phys_row(int p) { return p >= NBIG ? p : (p & ~255) + tileperm_inv(p & 255); }

template <bool IS_IN>
__device__ __forceinline__ void p0_transpose_item(const float* W, int N, const float* kscale, int kscale_n, bf16_t* WT, float* scr, int item, int lane) {
    const int nblk = (N + 63) / 64, kb = item / nblk, nb = item % nblk, k0 = 64 * kb, n0 = 64 * nb;
    const int colr = n0 + lane;
#pragma unroll
    for (int i = 0; i < 64; ++i) {
        float v = 0.f;
        if (colr < N) v = __builtin_nontemporal_load(W + (size_t)(k0 + i) * N + colr);
        const float sc = (k0 + i < kscale_n) ? kscale[k0 + i] : 1.f;
        scr[i * 65 + lane] = v * sc;
    }
    asm volatile("s_waitcnt lgkmcnt(0)" ::: "memory");
    const int c = lane & 7;
#pragma unroll
    for (int j = 0; j < 8; ++j) {
        const int n = (lane >> 3) + 8 * j; const int col = n0 + n;
        if (col < N) {
            const int row = IS_IN ? phys_row_of_logical(logical_col_in(col)) : phys_row_of_logical(col);
            const float* sp = scr + (8 * c) * 65 + n;
            u32x4 o; o.x = pk2(sp[0 * 65], sp[1 * 65]); o.y = pk2(sp[2 * 65], sp[3 * 65]); o.z = pk2(sp[4 * 65], sp[5 * 65]); o.w = pk2(sp[6 * 65], sp[7 * 65]);
            *(u32x4*)(WT + (size_t)row * DM + k0 + 8 * c) = o;
        }
    }
    asm volatile("s_waitcnt lgkmcnt(0)" ::: "memory");
}
__device__ __forceinline__ void rms_row_to_bf16(const float* xrow, bf16_t* orow, int lane) {
    const f32x4* xr = (const f32x4*)xrow + lane;
    f32x4 v[8]; float s = 0.f;
#pragma unroll
    for (int j = 0; j < 8; ++j) { v[j] = __builtin_nontemporal_load(xr + 64 * j); s += (v[j].x * v[j].x + v[j].y * v[j].y) + (v[j].z * v[j].z + v[j].w * v[j].w); }
    const float rstd = rsqrtf(wave_sum(s) * (1.f / DM) + EPS);
    unsigned long long* o8 = (unsigned long long*)orow + lane;
#pragma unroll
    for (int j = 0; j < 8; ++j) o8[64 * j] = (unsigned long long)pk2(v[j].x * rstd, v[j].y * rstd) | ((unsigned long long)pk2(v[j].z * rstd, v[j].w * rstd) << 32);
}
__device__ __forceinline__ float rope_inv(int i) {
    return i == 0 ? 1.0f : i == 1 ? 0.1939227432012558f : i == 2 ? 0.03760603070259094f : i == 3 ? 0.007292664609849453f : i == 4 ? 0.0014142135623842478f
         : i == 5 ? 0.00027424818836152554f : i == 6 ? 5.3182957344688475e-05f : 1.0313385246263351e-05f;
}
__device__ __forceinline__ void p0_prologue(const Ctx& c, unsigned char* lds, int G) {
    const int tid = threadIdx.x, lane = tid & 63, wave = tid >> 6;
    float* scr = (float*)(lds + wave * 16896);
    const int gw = blockIdx.x * NW + wave, NGW = G * NW;
    constexpr int I_IN = (DM / 64) * ((NCOL + 63) / 64), I_OUT = (DM / 64) * (DM / 64);
    for (int it = gw; it < I_IN + I_OUT; it += NGW) {
        if (it < I_IN) p0_transpose_item<true>(c.w_in, NCOL, c.norm_w, DM, c.wt_in, scr, it, lane);
        else p0_transpose_item<false>(c.w_out, DM, c.ssd_norm_w, 1024, c.wt_out, scr, it - I_IN, lane);
    }
    for (int m = gw; m < MP + MS; m += 2 * NGW) {
        const int m2 = m + NGW;
        const float* s0 = m < MP ? c.x_prompt + (size_t)m * DM : c.x_sample + (size_t)(m - MP) * DM;
        if (m2 < MP + MS) {
            const float* s1 = m2 < MP ? c.x_prompt + (size_t)m2 * DM : c.x_sample + (size_t)(m2 - MP) * DM;
            const f32x4* x0 = (const f32x4*)s0 + lane; const f32x4* x1 = (const f32x4*)s1 + lane;
            f32x4 v0[8], v1[8]; float q0 = 0.f, q1 = 0.f;
#pragma unroll
            for (int j = 0; j < 8; ++j) { v0[j] = x0[64 * j]; v1[j] = x1[64 * j]; }
#pragma unroll
            for (int j = 0; j < 8; ++j) { q0 += (v0[j].x * v0[j].x + v0[j].y * v0[j].y) + (v0[j].z * v0[j].z + v0[j].w * v0[j].w); q1 += (v1[j].x * v1[j].x + v1[j].y * v1[j].y) + (v1[j].z * v1[j].z + v1[j].w * v1[j].w); }
            const float r0 = rsqrtf(wave_sum(q0) * (1.f / DM) + EPS), r1 = rsqrtf(wave_sum(q1) * (1.f / DM) + EPS);
            unsigned long long* o0 = (unsigned long long*)(c.xn + (size_t)m * DM) + lane; unsigned long long* o1 = (unsigned long long*)(c.xn + (size_t)m2 * DM) + lane;
#pragma unroll
            for (int j = 0; j < 8; ++j) { o0[64 * j] = (unsigned long long)pk2(v0[j].x * r0, v0[j].y * r0) | ((unsigned long long)pk2(v0[j].z * r0, v0[j].w * r0) << 32);
                o1[64 * j] = (unsigned long long)pk2(v1[j].x * r1, v1[j].y * r1) | ((unsigned long long)pk2(v1[j].z * r1, v1[j].w * r1) << 32); }
        } else rms_row_to_bf16(s0, c.xn + (size_t)m * DM, lane);
    }
    for (int e = blockIdx.x * NT + tid; e < (TP + TS) * 8; e += G * NT) {
        const int pi = e >> 3, i = e & 7; const int pos = pi < TP ? pi : 16384 + (pi - TP);
        const float ang = (float)pos * rope_inv(i);
        float sn, cs; sincosf(ang, &sn, &cs);
        c.rope[2 * e] = cs; c.rope[2 * e + 1] = sn;
    }
}

struct EpiIn {
    static constexpr bool PERM = false, AFTER_DRAIN = false, RESCALE = false;
    bf16_t* proj; float* out; const float* rope; const float* qnw; const float* knw; bf16_t *vt1, *vt4, *vt16;
    __device__ __forceinline__ void operator()(const f32x4 (&acc)[2][2][4][2], const pg8::Unit& u, int wr, int wc, int fr, int fq) const {
        const int pn = u.pn;
        const int type = pn < 4 ? 0 : pn < 10 ? 1 : pn < 14 ? 2 : pn == 14 ? 3 : pn == 15 ? 4 : 5;
        const int col0 = pn * 256 + 64 * wc + 16 * fq;
#pragma unroll
        for (int ai = 0; ai < 2; ++ai)
#pragma unroll
            for (int m = 0; m < 4; ++m) {
                const int row = u.pm * 256 + ai * 128 + wr * 64 + m * 16 + fr;
                float v[16];
#pragma unroll
                for (int bj = 0; bj < 2; ++bj)
#pragma unroll
                    for (int n = 0; n < 2; ++n)
#pragma unroll
                        for (int e = 0; e < 4; ++e) v[8 * bj + 4 * n + e] = acc[ai][bj][m][n][e];
                if (type == 2 || type == 3) {
                    float ss = 0.f;
#pragma unroll
                    for (int i = 0; i < 16; ++i) ss += v[i] * v[i];
                    ss += __shfl_xor(ss, 16); ss += __shfl_xor(ss, 32);
                    const float rstd = rsqrtf(ss * (1.f / 64.f) + EPS);
                    const float* nw = (type == 2 ? qnw : knw) + 16 * fq;
#pragma unroll
                    for (int i = 0; i < 16; ++i) v[i] *= rstd * nw[i];
                    if (fq == 0) {
                        const float* rp = rope + (size_t)(row & (TP - 1)) * 16;
#pragma unroll
                        for (int i = 0; i < 8; ++i) { const float cs = rp[2 * i], sn = rp[2 * i + 1]; const float x1 = v[i], x2 = v[i + 8]; v[i] = x1 * cs - x2 * sn; v[i + 8] = x2 * cs + x1 * sn; }
                    }
                    if (type == 2) {
#pragma unroll
                        for (int i = 0; i < 16; ++i) v[i] *= QSCALE;
                    }
                } else if (type == 5 || type == 0) {
#pragma unroll
                    for (int i = 0; i < 16; ++i) v[i] = silu_f(v[i]);
                }
                if (type == 3 || type == 4) {
                    float* o = out + (type == 3 ? O_KP : O_VP) + (size_t)row * 256 + 64 * wc + 16 * fq;
#pragma unroll
                    for (int i = 0; i < 4; ++i) __builtin_nontemporal_store((f32x4){v[4 * i], v[4 * i + 1], v[4 * i + 2], v[4 * i + 3]}, (f32x4*)(o + 4 * i));
                }
                if (type == 1) {
                    const int t = row & (TP - 1);
                    if (t >= TP - 3) {
                        float* o = out + O_CP + (size_t)((row >> 11) * 3 + (t - (TP - 3))) * CONVD + (col0 - C_XBC);
#pragma unroll
                        for (int i = 0; i < 4; ++i) *(f32x4*)(o + 4 * i) = (f32x4){v[4 * i], v[4 * i + 1], v[4 * i + 2], v[4 * i + 3]};
                    }
                }
                u32x4 w0, w1;
                w0.x = pk2(v[0], v[1]); w0.y = pk2(v[2], v[3]); w0.z = pk2(v[4], v[5]); w0.w = pk2(v[6], v[7]);
                w1.x = pk2(v[8], v[9]); w1.y = pk2(v[10], v[11]); w1.z = pk2(v[12], v[13]); w1.w = pk2(v[14], v[15]);
                bf16_t* dst = proj + (size_t)row * NBIG + col0;
                *(u32x4*)dst = w0; *(u32x4*)(dst + 8) = w1;
            }
    }
};

__device__ __forceinline__ void skinny_unit(const bf16_t* X, const bf16_t* W, int kbeg, int kend, f32x4 (&acc)[2], int fr, int fq) {
    const bf16_t* xa = X + (size_t)fr * DM + 8 * fq; const bf16_t* xb = xa + 16 * DM; const bf16_t* wp = W + (size_t)fr * DM + 8 * fq;
#pragma unroll 8
    for (int k0 = kbeg; k0 < kend; k0 += 32) {
        const bf16x8 a0 = *(const bf16x8*)(xa + k0), a1 = *(const bf16x8*)(xb + k0), b = *(const bf16x8*)(wp + k0);
        acc[0] = __builtin_amdgcn_mfma_f32_16x16x32_bf16(a0, b, acc[0], 0, 0, 0);
        acc[1] = __builtin_amdgcn_mfma_f32_16x16x32_bf16(a1, b, acc[1], 0, 0, 0);
    }
}
__device__ __forceinline__ void p1_extras(const Ctx& c, int eb, int neb) {
    const int tid = threadIdx.x, lane = tid & 63, wave = tid >> 6, fr = lane & 15, fq = lane >> 4;
    constexpr int U_S = NCOL / 16, U_DT = MP / 32;
    for (int un = eb * NW + wave; un < U_S + U_DT; un += neb * NW) {
        f32x4 acc[2] = {{0.f, 0.f, 0.f, 0.f}, {0.f, 0.f, 0.f, 0.f}};
        if (un < U_S) {
            skinny_unit(c.xn + (size_t)MP * DM, c.wt_in + (size_t)un * 16 * DM, 0, DM, acc, fr, fq);
            const int lc = logical_of_phys_row(un * 16 + fr);
#pragma unroll
            for (int mt = 0; mt < 2; ++mt)
#pragma unroll
                for (int r = 0; r < 4; ++r) c.sproj[(size_t)(16 * mt + 4 * fq + r) * NCOL + lc] = acc[mt][r];
        } else {
            const int r0 = (un - U_S) * 32;
            skinny_unit(c.xn + (size_t)r0 * DM, c.wt_in + (size_t)NBIG * DM, 0, DM, acc, fr, fq);
            const float bias = c.dt_bias[fr];
#pragma unroll
            for (int mt = 0; mt < 2; ++mt)
#pragma unroll
                for (int r = 0; r < 4; ++r) c.dt[(size_t)(r0 + 16 * mt + 4 * fq + r) * 16 + fr] = softplus_f(acc[mt][r] + bias);
        }
    }
    constexpr int PER_B = 2044 * 256 / 4;
    constexpr int NCP = 2 * BS * PER_B;
    for (int i0 = eb * NT + tid; i0 < NCP; i0 += 8 * neb * NT) {
        f32x4 v[8];
#pragma unroll
        for (int u = 0; u < 8; ++u) { const int i = i0 + u * neb * NT; if (i < NCP) { const int which = i / (BS * PER_B), r = i % (BS * PER_B), b = r / PER_B, o = r % PER_B;
            v[u] = __builtin_nontemporal_load((const f32x4*)((which ? c.cache_v : c.cache_k) + (size_t)b * 2048 * 256 + 4 * 256) + o); } }
#pragma unroll
        for (int u = 0; u < 8; ++u) { const int i = i0 + u * neb * NT; if (i < NCP) { const int which = i / (BS * PER_B), r = i % (BS * PER_B), b = r / PER_B, o = r % PER_B;
            __builtin_nontemporal_store(v[u], (f32x4*)(c.out + (which ? O_VS : O_KS) + (size_t)b * 2048 * 256) + o); } }
    }
}

template <bool SAMPLE>
__device__ __forceinline__ void ssd_item(const Ctx& c, int b, int h, unsigned char* lds) {
    const int tid = threadIdx.x, p = tid >> 3, nq = tid & 7, g = h >> 3;
    constexpr int CH = 32;
    float* xs = (float*)lds;
    float* Bs = xs + CH * 64;
    float* Cs = Bs + CH * 128;
    float* zs = Cs + CH * 128;
    float* ys = zs + CH * 64;
    float* dts = ys + CH * 64;
    float* das = dts + CH;
    const int T = SAMPLE ? TS : TP;
    float hs[16];
    if (SAMPLE) {
        const f32x4* s = (const f32x4*)(c.state_ssm + ((size_t)(b * 16 + h) * 64 + p) * 128 + 16 * nq);
#pragma unroll
        for (int j = 0; j < 4; ++j) { const f32x4 v = s[j]; hs[4 * j] = v.x; hs[4 * j + 1] = v.y; hs[4 * j + 2] = v.z; hs[4 * j + 3] = v.w; }
    } else {
#pragma unroll
        for (int j = 0; j < 16; ++j) hs[j] = 0.f;
    }
    const float A = -__expf(c.a_log[h]), Dh = c.d_skip[h], dtb = c.dt_bias[h];
    for (int t0 = 0; t0 < T; t0 += CH) {
        const int nt = (T - t0) < CH ? (T - t0) : CH;
        __syncthreads();
        for (int idx = tid; idx < nt * 384; idx += NT) {
            const int tt = idx / 384, cc = idx % 384;
            if (cc < 320) {
                const int col = cc < 64 ? h * 64 + cc : cc < 192 ? 1024 + g * 128 + (cc - 64) : 1280 + g * 128 + (cc - 192);
                float a = c.conv_b[col];
#pragma unroll
                for (int k = 0; k < 4; ++k) {
                    const int ts = t0 + tt - 3 + k; float xv;
                    if (SAMPLE) xv = ts >= 0 ? c.sproj[(size_t)(b * TS + ts) * NCOL + C_XBC + col] : c.state_conv[(size_t)(b * 3 + (ts + 3)) * CONVD + col];
                    else xv = ts >= 0 ? bf2f(c.proj[(size_t)(b * TP + ts) * NBIG + C_XBC + col]) : 0.f;
                    a += c.conv_w[k * CONVD + col] * xv;
                }
                const float v = silu_f(a);
                if (cc < 64) xs[tt * 64 + cc] = v; else if (cc < 192) Bs[tt * 128 + cc - 64] = v; else Cs[tt * 128 + cc - 192] = v;
            } else {
                const int pc = cc - 320;
                const float z = SAMPLE ? c.sproj[(size_t)(b * TS + t0 + tt) * NCOL + C_Z + h * 64 + pc] : bf2f(c.proj[(size_t)(b * TP + t0 + tt) * NBIG + C_Z + h * 64 + pc]);
                zs[tt * 64 + pc] = silu_f(z);
            }
        }
        if (tid < nt) {
            const float dt = SAMPLE ? softplus_f(c.sproj[(size_t)(b * TS + t0 + tid) * NCOL + C_DT + h] + dtb) : c.dt[(size_t)(b * TP + t0 + tid) * 16 + h];
            dts[tid] = dt; das[tid] = __expf(dt * A);
        }
        __syncthreads();
        for (int tt = 0; tt < nt; ++tt) {
            const float dt = dts[tt], dA = das[tt], xv = xs[tt * 64 + p], dx = dt * xv;
            const f32x4* bp = (const f32x4*)(Bs + tt * 128 + 16 * nq); const f32x4* cp = (const f32x4*)(Cs + tt * 128 + 16 * nq);
            float y = 0.f;
#pragma unroll
            for (int j = 0; j < 4; ++j) {
                const f32x4 bv = bp[j], cv = cp[j];
                hs[4 * j] = hs[4 * j] * dA + dx * bv.x; y += hs[4 * j] * cv.x;
                hs[4 * j + 1] = hs[4 * j + 1] * dA + dx * bv.y; y += hs[4 * j + 1] * cv.y;
                hs[4 * j + 2] = hs[4 * j + 2] * dA + dx * bv.z; y += hs[4 * j + 2] * cv.z;
                hs[4 * j + 3] = hs[4 * j + 3] * dA + dx * bv.w; y += hs[4 * j + 3] * cv.w;
            }
            y += __shfl_xor(y, 1); y += __shfl_xor(y, 2); y += __shfl_xor(y, 4);
            if (nq == 0) ys[tt * 64 + p] = (y + Dh * xv) * zs[tt * 64 + p];
        }
        __syncthreads();
        {
            const int tt = tid >> 4, pq = tid & 15;
            f32x4 v = {0.f, 0.f, 0.f, 0.f};
            if (tt < nt) v = *(const f32x4*)(ys + tt * 64 + 4 * pq);
            float ss = (v.x * v.x + v.y * v.y) + (v.z * v.z + v.w * v.w);
            ss += __shfl_xor(ss, 1); ss += __shfl_xor(ss, 2); ss += __shfl_xor(ss, 4); ss += __shfl_xor(ss, 8);
            if (tt < nt) {
                const size_t row = SAMPLE ? (size_t)(MP + b * TS + t0 + tt) : (size_t)(b * TP + t0 + tt);
                *(unsigned long long*)(c.ymix + row * DM + h * 64 + 4 * pq) = (unsigned long long)pk2(v.x, v.y) | ((unsigned long long)pk2(v.z, v.w) << 32);
                if (pq == 0) c.ssq[row * 16 + h] = ss;
            }
        }
    }
    {
        f32x4* d = (f32x4*)(c.out + (SAMPLE ? O_HS : O_HP) + ((size_t)(b * 16 + h) * 64 + p) * 128 + 16 * nq);
#pragma unroll
        for (int j = 0; j < 4; ++j) d[j] = (f32x4){hs[4 * j], hs[4 * j + 1], hs[4 * j + 2], hs[4 * j + 3]};
    }
    if (SAMPLE) {
        for (int i = tid; i < 3 * 96; i += NT) { const int j = i / 96, cc = h * 96 + i % 96; c.out[O_CS + (size_t)(b * 3 + j) * CONVD + cc] = c.sproj[(size_t)(b * TS + 1 + j) * NCOL + C_XBC + cc]; }
    }
    __syncthreads();
}

typedef unsigned u32x2v __attribute__((ext_vector_type(2)));

constexpr int PB = 136, PX = 72;
typedef short v4i16_t __attribute__((ext_vector_type(4)));
__device__ __forceinline__ u32x2v tr_read(const bf16_t* p) { return __builtin_bit_cast(u32x2v, __builtin_amdgcn_ds_read_tr16_b64_v4i16((LAS v4i16_t*)p)); }
__device__ __forceinline__ bf16x8 tr_pair(const bf16_t* p0, const bf16_t* p1) { const u32x2v a = tr_read(p0), b = tr_read(p1); const u32x4 w = {a.x, a.y, b.x, b.y}; return __builtin_bit_cast(bf16x8, w); }
__device__ __forceinline__ u32x4 pack8(const float (&v)[8]) { u32x4 w; w.x = pk2(v[0], v[1]); w.y = pk2(v[2], v[3]); w.z = pk2(v[4], v[5]); w.w = pk2(v[6], v[7]); return w; }
constexpr int PXQ = 264;
__device__ __forceinline__ void ssd_a_item(const Ctx& c, int item, unsigned char* lds) {
    const int tid = threadIdx.x, lane = tid & 63, wave = __builtin_amdgcn_readfirstlane(tid >> 6); int fr = lane & 15, fq = lane >> 4;
    const int hh = item & 1, g = (item >> 1) & 1, ch = (item >> 2) & 15, b = item >> 6, h0 = 8 * g + 4 * hh;
    bf16_t* Bs = (bf16_t*)lds; bf16_t* Cs = Bs + 128 * PB; bf16_t* Xs = Cs + 128 * PB;
    float* cumA = (float*)(Xs + 128 * PXQ); float* dtsA = cumA + 512; float* wA = dtsA + 512;
    const size_t rowb = (size_t)b * TP + ch * 128;
    __syncthreads();
    if (wave < 4) {
        const int h = h0 + wave; const float A = -__expf(c.a_log[h]);
        const float d0 = c.dt[(rowb + 2 * lane) * 16 + h], d1 = c.dt[(rowb + 2 * lane + 1) * 16 + h];
        const float x0 = A * d0, x1 = A * d1; float incl = x0 + x1;
#pragma unroll
        for (int off = 1; off < 64; off <<= 1) { const float t = __shfl_up(incl, off); if (lane >= off) incl += t; }
        const float c1 = incl, c0 = incl - x1, cl = __shfl(c1, 63);
        cumA[wave * 128 + 2 * lane] = c0; cumA[wave * 128 + 2 * lane + 1] = c1; dtsA[wave * 128 + 2 * lane] = d0; dtsA[wave * 128 + 2 * lane + 1] = d1;
        wA[wave * 128 + 2 * lane] = __expf(cl - c0) * d0; wA[wave * 128 + 2 * lane + 1] = __expf(cl - c1) * d1;
        c.el[(rowb + 2 * lane) * 16 + h] = __expf(c0); c.el[(rowb + 2 * lane + 1) * 16 + h] = __expf(c1);
        if (lane == 63) c.cd[(b * 16 + ch) * 16 + h] = __expf(c1);
    }
    {
        const int o = lane;
        const int xcol = o < 32 ? h0 * 64 + 8 * o : o < 48 ? 1024 + g * 128 + 8 * (o - 32) : 1280 + g * 128 + 8 * (o - 48);
        float cwr[5][8];
#pragma unroll
        for (int k = 0; k < 5; ++k) { const float* wp = (k < 4 ? c.conv_w + k * CONVD : c.conv_b) + xcol; const f32x4 a = *(const f32x4*)wp, b2 = *(const f32x4*)(wp + 4);
            cwr[k][0] = a.x; cwr[k][1] = a.y; cwr[k][2] = a.z; cwr[k][3] = a.w; cwr[k][4] = b2.x; cwr[k][5] = b2.y; cwr[k][6] = b2.z; cwr[k][7] = b2.w; }
        const bf16_t* src = c.proj + (size_t)(b * TP) * NBIG + C_XBC + xcol;
#pragma unroll 1
        for (int hf = 0; hf < 2; ++hf) {
            const int s0 = 16 * wave + 8 * hf;
            u32x4 raw[11];
#pragma unroll
            for (int j = 0; j < 11; ++j) { const int t = ch * 128 + s0 - 3 + j; raw[j] = (u32x4){0u, 0u, 0u, 0u}; if (t >= 0) raw[j] = *(const u32x4*)(src + (size_t)t * NBIG); }
#pragma unroll
            for (int i = 0; i < 8; ++i) {
                float v[8];
#pragma unroll
                for (int e = 0; e < 8; ++e) v[e] = cwr[4][e];
#pragma unroll
                for (int k = 0; k < 4; ++k) { const u32x4 u = raw[i + k];
                    v[0] += cwr[k][0] * bf_lo(u.x); v[1] += cwr[k][1] * bf_hi(u.x); v[2] += cwr[k][2] * bf_lo(u.y); v[3] += cwr[k][3] * bf_hi(u.y);
                    v[4] += cwr[k][4] * bf_lo(u.z); v[5] += cwr[k][5] * bf_hi(u.z); v[6] += cwr[k][6] * bf_lo(u.w); v[7] += cwr[k][7] * bf_hi(u.w); }
#pragma unroll
                for (int e = 0; e < 8; ++e) v[e] = silu_f(v[e]);
                const u32x4 pw = pack8(v); const int sidx = s0 + i;
                if (o < 32) *(u32x4*)(Xs + sidx * PXQ + 8 * o) = pw;
                else if (o < 48) *(u32x4*)(Bs + sidx * PB + 8 * (o - 32)) = pw;
                else { *(u32x4*)(Cs + sidx * PB + 8 * (o - 48)) = pw; if (hh == 0) *(u32x4*)(c.xcc + (rowb + sidx) * 256 + g * 128 + 8 * (o - 48)) = pw; }
            }
        }
    }
    __syncthreads();
    asm volatile("" : "+v"(fr), "+v"(fq));
    const int l = 16 * wave + fr;
    f32x4 ga[4], gb[4];
    {
        bf16x8 cf[4];
#pragma unroll
        for (int kk = 0; kk < 4; ++kk) cf[kk] = *(const bf16x8*)(Cs + l * PB + 8 * fq + 32 * kk);
#pragma unroll
        for (int ks = 0; ks < 4; ++ks) {
            ga[ks] = (f32x4){0.f, 0.f, 0.f, 0.f}; gb[ks] = (f32x4){0.f, 0.f, 0.f, 0.f};
            if (ks <= (wave >> 1)) {
#pragma unroll
                for (int kk = 0; kk < 4; ++kk) ga[ks] = __builtin_amdgcn_mfma_f32_16x16x32_bf16(*(const bf16x8*)(Bs + (32 * ks + fr) * PB + 8 * fq + 32 * kk), cf[kk], ga[ks], 0, 0, 0);
                if (2 * ks + 1 <= wave) {
#pragma unroll
                    for (int kk = 0; kk < 4; ++kk) gb[ks] = __builtin_amdgcn_mfma_f32_16x16x32_bf16(*(const bf16x8*)(Bs + (32 * ks + 16 + fr) * PB + 8 * fq + 32 * kk), cf[kk], gb[ks], 0, 0, 0);
                }
            }
        }
    }
    const int spt = wave & 3, snh = wave >> 2;
#pragma unroll 1
    for (int j = 0; j < 4; ++j) {
        const int h = h0 + j; const float Dh = c.d_skip[h];
        const float* cumj = cumA + j * 128; const float* dtj = dtsA + j * 128; const float* wj = wA + j * 128;
        const float cl_l = cumj[l];
        f32x4 acc[4];
#pragma unroll
        for (int pt = 0; pt < 4; ++pt) acc[pt] = (f32x4){0.f, 0.f, 0.f, 0.f};
#pragma unroll
        for (int ks = 0; ks < 4; ++ks) {
            if (ks <= (wave >> 1)) {
                const f32x4 ca = *(const f32x4*)(cumj + 32 * ks + 4 * fq), cb = *(const f32x4*)(cumj + 32 * ks + 16 + 4 * fq);
                const f32x4 da = *(const f32x4*)(dtj + 32 * ks + 4 * fq), db = *(const f32x4*)(dtj + 32 * ks + 16 + 4 * fq);
                float m[8];
#pragma unroll
                for (int e = 0; e < 4; ++e) {
                    const int sA = 32 * ks + 4 * fq + e;
                    m[e] = (sA <= l) ? ga[ks][e] * __expf(cl_l - ca[e]) * da[e] : 0.f;
                    m[4 + e] = (sA + 16 <= l) ? gb[ks][e] * __expf(cl_l - cb[e]) * db[e] : 0.f;
                }
                const bf16x8 mb = __builtin_bit_cast(bf16x8, pack8(m));
#pragma unroll
                for (int pt = 0; pt < 4; ++pt) {
                    const bf16_t* xp = Xs + (32 * ks + 4 * fq + (fr >> 2)) * PXQ + 64 * j + 16 * pt + 4 * (fr & 3);
                    acc[pt] = __builtin_amdgcn_mfma_f32_16x16x32_bf16(tr_pair(xp, xp + 16 * PXQ), mb, acc[pt], 0, 0, 0);
                }
            }
        }
#pragma unroll
        for (int pt = 0; pt < 4; ++pt) {
            const int p0 = 16 * pt + 4 * fq;
            const u32x2v xv = *(const u32x2v*)(Xs + l * PXQ + 64 * j + p0);
            const f32x4 y = {acc[pt][0] + Dh * bf_lo(xv.x), acc[pt][1] + Dh * bf_hi(xv.x), acc[pt][2] + Dh * bf_lo(xv.y), acc[pt][3] + Dh * bf_hi(xv.y)};
            *(f32x4*)(c.yd + (rowb + l) * 1024 + h * 64 + p0) = y;
        }
        f32x4 sacc[4];
#pragma unroll
        for (int nt = 0; nt < 4; ++nt) sacc[nt] = (f32x4){0.f, 0.f, 0.f, 0.f};
#pragma unroll
        for (int ks = 0; ks < 4; ++ks) {
            const bf16_t* xp = Xs + (32 * ks + 8 * fq + (fr >> 2)) * PXQ + 64 * j + 16 * spt + 4 * (fr & 3);
            const u32x2v xa = tr_read(xp), xb = tr_read(xp + 4 * PXQ);
            const f32x4 wa = *(const f32x4*)(wj + 32 * ks + 8 * fq), wb = *(const f32x4*)(wj + 32 * ks + 8 * fq + 4);
            u32x4 xw; xw.x = pk2(bf_lo(xa.x) * wa.x, bf_hi(xa.x) * wa.y); xw.y = pk2(bf_lo(xa.y) * wa.z, bf_hi(xa.y) * wa.w);
            xw.z = pk2(bf_lo(xb.x) * wb.x, bf_hi(xb.x) * wb.y); xw.w = pk2(bf_lo(xb.y) * wb.z, bf_hi(xb.y) * wb.w);
            const bf16x8 xf = __builtin_bit_cast(bf16x8, xw);
#pragma unroll
            for (int nt = 0; nt < 4; ++nt) { const bf16_t* bp = Bs + (32 * ks + 8 * fq + (fr >> 2)) * PB + 16 * (4 * snh + nt) + 4 * (fr & 3);
                sacc[nt] = __builtin_amdgcn_mfma_f32_16x16x32_bf16(xf, tr_pair(bp, bp + 4 * PB), sacc[nt], 0, 0, 0); }
        }
        float* sp = c.st + ((size_t)((b * 16 + ch) * 16 + h)) * 8192 + (size_t)(16 * spt + 4 * fq) * 128 + 16 * (4 * snh) + fr;
#pragma unroll
        for (int nt = 0; nt < 4; ++nt)
#pragma unroll
            for (int e = 0; e < 4; ++e) sp[e * 128 + 16 * nt] = sacc[nt][e];
    }
}
__device__ __forceinline__ void ssd_chain_item(const Ctx& c, int b, int h, unsigned char* lds) {
    const int tid = threadIdx.x, lane = tid & 63, wave = __builtin_amdgcn_readfirstlane(tid >> 6), g = h >> 3; int fr = lane & 15, fq = lane >> 4;
    bf16_t* hB = (bf16_t*)lds;
    const int hp = tid >> 3, hn = 16 * (tid & 7);
    float hs[16];
#pragma unroll
    for (int i = 0; i < 16; ++i) hs[i] = 0.f;
    __syncthreads();
    { const u32x4 z4 = {0u, 0u, 0u, 0u}; *(u32x4*)(hB + hp * PB + hn) = z4; *(u32x4*)(hB + hp * PB + hn + 8) = z4; }
    const float* stp = c.st + ((size_t)(b * 16) * 16 + h) * 8192 + (size_t)hp * 128 + hn;
    f32x4 stn[2][4]; bf16x8 cfn[2][4]; f32x4 ydn[2][4]; u32x2v zn[2][4]; float eln[2], cdn[2];
#define CHAIN_LOAD(chx, S) do { const size_t r_ = (size_t)b * TP + (chx) * 128 + 16 * wave + fr; \
        _Pragma("unroll") for (int i = 0; i < 4; ++i) stn[S][i] = *(const f32x4*)(stp + (size_t)(chx) * 16 * 8192 + 4 * i); \
        _Pragma("unroll") for (int kk = 0; kk < 4; ++kk) cfn[S][kk] = *(const bf16x8*)(c.xcc + r_ * 256 + g * 128 + 8 * fq + 32 * kk); \
        _Pragma("unroll") for (int pt = 0; pt < 4; ++pt) { ydn[S][pt] = *(const f32x4*)(c.yd + r_ * 1024 + h * 64 + 16 * pt + 4 * fq); zn[S][pt] = *(const u32x2v*)(c.proj + r_ * NBIG + C_Z + h * 64 + 16 * pt + 4 * fq); } \
        eln[S] = c.el[r_ * 16 + h]; cdn[S] = c.cd[(b * 16 + (chx)) * 16 + h]; } while (0)
    CHAIN_LOAD(0, 0); CHAIN_LOAD(1, 1);
    __syncthreads();
#pragma unroll 1
    for (int ch2 = 0; ch2 < 16; ch2 += 2) {
        asm volatile("" : "+v"(fr), "+v"(fq));
#pragma unroll
        for (int j = 0; j < 2; ++j) {
        const int ch = ch2 + j;
        const size_t orow = (size_t)b * TP + ch * 128 + 16 * wave + fr;
        bf16x8 cf[4]; f32x4 ydr[4]; u32x2v zr[4]; f32x4 stc[4];
#pragma unroll
        for (int i = 0; i < 4; ++i) { cf[i] = cfn[j][i]; ydr[i] = ydn[j][i]; zr[i] = zn[j][i]; stc[i] = stn[j][i]; }
        const float el = eln[j], cdv = cdn[j];
        if (ch + 2 < 16) CHAIN_LOAD(ch + 2, j);
        float ss = 0.f;
#pragma unroll
        for (int pt = 0; pt < 4; ++pt) {
            f32x4 acc = {0.f, 0.f, 0.f, 0.f};
#pragma unroll
            for (int kk = 0; kk < 4; ++kk) acc = __builtin_amdgcn_mfma_f32_16x16x32_bf16(*(const bf16x8*)(hB + (16 * pt + fr) * PB + 8 * fq + 32 * kk), cf[kk], acc, 0, 0, 0);
            const float y0 = (ydr[pt][0] + el * acc[0]) * bf_lo(zr[pt].x), y1 = (ydr[pt][1] + el * acc[1]) * bf_hi(zr[pt].x);
            const float y2 = (ydr[pt][2] + el * acc[2]) * bf_lo(zr[pt].y), y3 = (ydr[pt][3] + el * acc[3]) * bf_hi(zr[pt].y);
            ss += (y0 * y0 + y1 * y1) + (y2 * y2 + y3 * y3);
            u32x2v w; w.x = pk2(y0, y1); w.y = pk2(y2, y3);
            *(u32x2v*)(c.ymix + orow * DM + h * 64 + 16 * pt + 4 * fq) = w;
        }
        ss += __shfl_xor(ss, 16); ss += __shfl_xor(ss, 32);
        if (fq == 0) c.ssq[orow * 16 + h] = ss;
#pragma unroll
        for (int i = 0; i < 4; ++i) { hs[4 * i] = hs[4 * i] * cdv + stc[i].x; hs[4 * i + 1] = hs[4 * i + 1] * cdv + stc[i].y; hs[4 * i + 2] = hs[4 * i + 2] * cdv + stc[i].z; hs[4 * i + 3] = hs[4 * i + 3] * cdv + stc[i].w; }
        __syncthreads();
        { u32x4 w0, w1; w0.x = pk2(hs[0], hs[1]); w0.y = pk2(hs[2], hs[3]); w0.z = pk2(hs[4], hs[5]); w0.w = pk2(hs[6], hs[7]);
          w1.x = pk2(hs[8], hs[9]); w1.y = pk2(hs[10], hs[11]); w1.z = pk2(hs[12], hs[13]); w1.w = pk2(hs[14], hs[15]);
          *(u32x4*)(hB + hp * PB + hn) = w0; *(u32x4*)(hB + hp * PB + hn + 8) = w1; }
        __syncthreads();
        }
    }
#undef CHAIN_LOAD
    {
        f32x4* d = (f32x4*)(c.out + O_HP + ((size_t)(b * 16 + h) * 64 + hp) * 128 + hn);
#pragma unroll
        for (int i = 0; i < 4; ++i) __builtin_nontemporal_store((f32x4){hs[4 * i], hs[4 * i + 1], hs[4 * i + 2], hs[4 * i + 3]}, d + i);
    }
    __syncthreads();
}

__device__ __forceinline__ int att_off(int e, bool& in_range) {
    in_range = e < 387;
    const int br = e < 129 ? 0 : e < 258 ? 1 : 2; const int j = e - 129 * br;
    return br == 0 ? j : br == 1 ? 4 * j : 16 * j;
}
__device__ __forceinline__ void attn_branch2(const bf16_t* Kb  , const bf16_t* Vt  , const bf16x8* qs, f32x4 (&o)[4][4], float (&l)[4],
                                             int t0, int r, int fr, int fq, float bnd, bf16_t* vls, int lane) {
    const int qp = fr >> 2, ur = (t0 >> 4) + qp;
    const int nsteps = (((t0 >> 4) + 4) + 31) >> 5;
#pragma unroll
    for (int cp = 0; cp < 2; ++cp) {
#pragma unroll 1
        for (int st = 0; st < nsteps; ++st) {
            const int ustep = 32 * st;
            bf16x8 kA[2][2], kB[2][2];
#pragma unroll
            for (int x = 0; x < 2; ++x) {
                const int cc = 2 * cp + x;
                const int sA = 16 * (ustep + fr) + 4 * cc + r, sB = sA + 256;
                const bf16_t* pa = Kb + (size_t)sA * NBIG; const bf16_t* pb = Kb + (size_t)(sB > 2047 ? 2047 : sB) * NBIG;
                kA[x][0] = *(const bf16x8*)pa; kA[x][1] = *(const bf16x8*)(pa + 32); kB[x][0] = *(const bf16x8*)pb; kB[x][1] = *(const bf16x8*)(pb + 32);
            }
            u32x4 vraw[2][4];
#pragma unroll
            for (int x = 0; x < 2; ++x) {
                const int cc = 2 * cp + x;
#pragma unroll
                for (int i = 0; i < 4; ++i) { int pos = 16 * (ustep + (lane >> 3) + 8 * i) + 4 * cc + r; pos = pos > TP - 1 ? TP - 1 : pos; vraw[x][i] = *(const u32x4*)(Vt + (size_t)pos * NBIG + 8 * (lane & 7)); }
            }
#pragma unroll
            for (int x = 0; x < 2; ++x) {
                const int c = 2 * cp + x;
                const bf16x8 q0 = qs[(2 * c) * 64], q1 = qs[(2 * c + 1) * 64];
                f32x4 sa = {0.f, 0.f, 0.f, 0.f}, sb = {0.f, 0.f, 0.f, 0.f};
                sa = __builtin_amdgcn_mfma_f32_16x16x32_bf16(kA[x][0], q0, sa, 0, 0, 0); sa = __builtin_amdgcn_mfma_f32_16x16x32_bf16(kA[x][1], q1, sa, 0, 0, 0);
                sb = __builtin_amdgcn_mfma_f32_16x16x32_bf16(kB[x][0], q0, sb, 0, 0, 0); sb = __builtin_amdgcn_mfma_f32_16x16x32_bf16(kB[x][1], q1, sb, 0, 0, 0);
                const int dA = ur - (ustep + 4 * fq);
                float p[8]; float ls = 0.f;
#pragma unroll
                for (int e = 0; e < 4; ++e) {
                    const int d0 = dA - e, d1 = dA - 16 - e;
                    p[e] = d0 >= 0 ? __builtin_amdgcn_exp2f(sa[e] - bnd) : 0.f; p[4 + e] = d1 >= 0 ? __builtin_amdgcn_exp2f(sb[e] - bnd) : 0.f;
                    ls += p[e] + p[4 + e];
                }
                l[c] += ls;
                const u32x4 pw = {pk2(p[0], p[1]), pk2(p[2], p[3]), pk2(p[4], p[5]), pk2(p[6], p[7])};
                const bf16x8 pbf = __builtin_bit_cast(bf16x8, pw);
                bf16x8 vf[4];
                {
                    bf16_t* vl = vls + x * 2048;
                    asm volatile("" ::: "memory");
#pragma unroll
                    for (int i = 0; i < 4; ++i) *(u32x4*)(vl + ((lane >> 3) + 8 * i) * 64 + 8 * (lane & 7)) = vraw[x][i];
                    asm volatile("" ::: "memory");
#pragma unroll
                    for (int dt = 0; dt < 4; ++dt) { const bf16_t* vp = vl + (4 * fq + (fr >> 2)) * 64 + 16 * dt + 4 * (fr & 3); vf[dt] = tr_pair(vp, vp + 16 * 64); }
                    asm volatile("" ::: "memory");
                }
#pragma unroll
                for (int dt = 0; dt < 4; ++dt) o[c][dt] = __builtin_amdgcn_mfma_f32_16x16x32_bf16(vf[dt], pbf, o[c][dt], 0, 0, 0);
            }
        }
    }
}
template <int BR>
__device__ __forceinline__ void attn_branch(const bf16_t* Kb  , const bf16_t* Vt  , const bf16x8* qs  , f32x4 (&o)[4][4], float (&l)[4],
                                            int t0, int r, int fr, int fq, float bnd, bf16_t* vls  , int lane) {
    constexpr int DIL = BR == 0 ? 1 : BR == 1 ? 4 : 16, LEN = 2048 / DIL;
    const int qp = fr >> 2;
    const int ukbase = BR == 0 ? t0 - 128 : BR == 1 ? (t0 >> 2) - 128 : 0;
    const int nsteps = BR == 0 ? 6 : BR == 1 ? 5 : (((t0 >> 4) + 4) + 31) >> 5;
    const int first = ukbase < 0 ? ((-ukbase) >> 5) : 0;
#pragma unroll
    for (int cc = 0; cc < (BR == 2 ? 4 : 1); ++cc) {
        bf16x8 kAn[2], kBn[2];
#define ATT_LOADK(stp) do { const int us_ = ukbase + 32 * (stp); \
            int uA = us_ + fr, uB = uA + 16; uA = uA < 0 ? 0 : uA; uB = uB < 0 ? 0 : uB; \
            const int sA = BR == 0 ? uA : BR == 1 ? 4 * uA + r : 16 * uA + 4 * cc + r, sB = BR == 0 ? uB : BR == 1 ? 4 * uB + r : 16 * uB + 4 * cc + r; \
            const bf16_t* pa = Kb + (size_t)sA * NBIG; const bf16_t* pb = Kb + (size_t)sB * NBIG; \
            kAn[0] = *(const bf16x8*)pa; kAn[1] = *(const bf16x8*)(pa + 32); kBn[0] = *(const bf16x8*)pb; kBn[1] = *(const bf16x8*)(pb + 32); } while (0)
        if (first < nsteps) ATT_LOADK(first);
#pragma unroll 1
        for (int st = first; st < nsteps; ++st) {
            const int ustep = ukbase + 32 * st;
            bf16x8 kA[2], kB[2], vf[4];
            kA[0] = kAn[0]; kA[1] = kAn[1]; kB[0] = kBn[0]; kB[1] = kBn[1];
            u32x4 vraw[4];
#pragma unroll
            for (int i = 0; i < 4; ++i) {
                int u = ustep + (lane >> 3) + 8 * i; u = u < 0 ? 0 : u;
                int pos = BR == 0 ? u : 4 * u + r; pos = pos > TP - 1 ? TP - 1 : pos;
                vraw[i] = *(const u32x4*)(Vt + (size_t)pos * NBIG + 8 * (lane & 7));
            }
            if (st + 1 < nsteps) ATT_LOADK(st + 1);
#pragma unroll
            for (int c4 = 0; c4 < (BR == 2 ? 1 : 4); ++c4) {
                const int c = BR == 2 ? cc : c4;
                f32x4 sa = {0.f, 0.f, 0.f, 0.f}, sb = {0.f, 0.f, 0.f, 0.f};
                const bf16x8 q0 = qs[(2 * c) * 64], q1 = qs[(2 * c + 1) * 64];
                sa = __builtin_amdgcn_mfma_f32_16x16x32_bf16(kA[0], q0, sa, 0, 0, 0); sa = __builtin_amdgcn_mfma_f32_16x16x32_bf16(kA[1], q1, sa, 0, 0, 0);
                sb = __builtin_amdgcn_mfma_f32_16x16x32_bf16(kB[0], q0, sb, 0, 0, 0); sb = __builtin_amdgcn_mfma_f32_16x16x32_bf16(kB[1], q1, sb, 0, 0, 0);
                const int ur = BR == 0 ? t0 + 16 * qp + 4 * c + r : BR == 1 ? (t0 >> 2) + 4 * qp + c : (t0 >> 4) + qp;
                const int dA = ur - (ustep + 4 * fq);
                float p[8]; float ls = 0.f;
#pragma unroll
                for (int e = 0; e < 4; ++e) {
                    const int d0 = dA - e, d1 = dA - 16 - e;
                    const bool v0 = d0 >= 0 && d0 <= 128 && d0 <= ur, v1 = d1 >= 0 && d1 <= 128 && d1 <= ur;
                    p[e] = v0 ? __builtin_amdgcn_exp2f(sa[e] - bnd) : 0.f; p[4 + e] = v1 ? __builtin_amdgcn_exp2f(sb[e] - bnd) : 0.f;
                    ls += p[e] + p[4 + e];
                }
                l[c] += ls;
                const u32x4 pw = {pk2(p[0], p[1]), pk2(p[2], p[3]), pk2(p[4], p[5]), pk2(p[6], p[7])};
                const bf16x8 pb = __builtin_bit_cast(bf16x8, pw);
                if (c4 == 0) {
                    asm volatile("" ::: "memory");
#pragma unroll
                    for (int i = 0; i < 4; ++i) *(u32x4*)(vls + ((lane >> 3) + 8 * i) * 64 + 8 * (lane & 7)) = vraw[i];
                    asm volatile("" ::: "memory");
#pragma unroll
                    for (int dt = 0; dt < 4; ++dt) { const bf16_t* vp = vls + (4 * fq + (fr >> 2)) * 64 + 16 * dt + 4 * (fr & 3); vf[dt] = tr_pair(vp, vp + 16 * 64); }
                    asm volatile("" ::: "memory");
                }
#pragma unroll
                for (int dt = 0; dt < 4; ++dt) o[c][dt] = __builtin_amdgcn_mfma_f32_16x16x32_bf16(vf[dt], pb, o[c][dt], 0, 0, 0);
            }
        }
#undef ATT_LOADK
    }
}
__device__ __forceinline__ void attn_prompt_mfma(const Ctx& c, int item, int lane, float bnd, bf16x8* qs, bf16_t* vls) {
    const int fr = lane & 15, fq = lane >> 4, g = fr & 3, qp = fr >> 2;
    const int tile = 31 - (item >> 6), rest = item & 63, b = rest >> 4, kvh = (rest >> 2) & 3, r = rest & 3, t0 = tile * 64;
    const size_t row0 = (size_t)b * TP + t0 + 16 * qp + r;
    {
        const bf16_t* Qb = c.proj + row0 * NBIG + C_Q + (kvh * 4 + g) * 64 + 8 * fq;
#pragma unroll
        for (int cq = 0; cq < 4; ++cq) { qs[(2 * cq) * 64] = *(const bf16x8*)(Qb + (size_t)(4 * cq) * NBIG); qs[(2 * cq + 1) * 64] = *(const bf16x8*)(Qb + (size_t)(4 * cq) * NBIG + 32); }
    }
    f32x4 o[4][4]; float l[4];
#pragma unroll
    for (int cq = 0; cq < 4; ++cq) { l[cq] = 0.f;
#pragma unroll
        for (int dt = 0; dt < 4; ++dt) o[cq][dt] = (f32x4){0.f, 0.f, 0.f, 0.f}; }
    const bf16_t* Kb = c.proj + (size_t)b * TP * NBIG + C_K + kvh * 64 + 8 * fq;
    const int bk = b * 4 + kvh;
    const bf16_t* Vb = c.proj + (size_t)b * TP * NBIG + C_V + kvh * 64;
    attn_branch<0>(Kb, Vb, qs, o, l, t0, r, fr, fq, bnd, vls, lane);
    attn_branch<1>(Kb, Vb, qs, o, l, t0, r, fr, fq, bnd, vls, lane);
    attn_branch2(Kb, Vb, qs, o, l, t0, r, fr, fq, bnd, vls, lane);
#pragma unroll
    for (int cq = 0; cq < 4; ++cq) {
        float ls = l[cq]; ls += __shfl_xor(ls, 16); ls += __shfl_xor(ls, 32);
        const float inv = 1.f / ls;
        const size_t row = row0 + 4 * cq;
        const bf16_t* gp = c.proj + row * NBIG + C_G + (kvh * 4 + g) * 64 + 4 * fq;
        bf16_t* yp = c.ymix + row * DM + 1024 + (kvh * 4 + g) * 64 + 4 * fq;
#pragma unroll
        for (int dt = 0; dt < 4; ++dt) {
            const u32x2v gw = *(const u32x2v*)(gp + 16 * dt);
            u32x2v w; w.x = pk2(o[cq][dt][0] * inv * bf_lo(gw.x), o[cq][dt][1] * inv * bf_hi(gw.x)); w.y = pk2(o[cq][dt][2] * inv * bf_lo(gw.y), o[cq][dt][3] * inv * bf_hi(gw.y));
            *(u32x2v*)(yp + 16 * dt) = w;
        }
    }
}
__device__ __forceinline__ float norm_rope_lane(float raw, const float* nw, const float* rope, int pidx, int lane) {
    const float ss = wave_sum(raw * raw);
    const float v = raw * rsqrtf(ss * (1.f / 64.f) + EPS) * nw[lane];
    const float partner = __shfl_xor(v, 8);
    const float cs = rope[(size_t)pidx * 16 + 2 * (lane & 7)], sn = rope[(size_t)pidx * 16 + 2 * (lane & 7) + 1];
    return lane < 8 ? v * cs - partner * sn : lane < 16 ? v * cs + partner * sn : v;
}
__device__ __forceinline__ void attn_sample_wave(const Ctx& c, int item, int lane, float* sl  , float* wl  ) {
    const int br = item % 3, rest = item / 3, kvh = rest & 3, i = (rest >> 2) & 3, b = rest >> 4;
    const int dil = br == 0 ? 1 : br == 1 ? 4 : 16;
    float vnew[4];
#pragma unroll
    for (int j = 0; j < 4; ++j) {
        const float* sp = c.sproj + (size_t)(b * TS + j) * NCOL;
        const float kn = norm_rope_lane(sp[C_K + kvh * 64 + lane], c.k_norm_w, c.rope, TP + j, lane);
        vnew[j] = sp[C_V + kvh * 64 + lane];
        wl[j * 64 + lane] = kn;
        if (i == 3 && br == 0) {
            c.out[O_KS + ((size_t)(b * 2048 + 2044 + j) * 4 + kvh) * 64 + lane] = kn;
            c.out[O_VS + ((size_t)(b * 2048 + 2044 + j) * 4 + kvh) * 64 + lane] = vnew[j];
        }
    }
    const float* CK = c.cache_k + (size_t)b * 2048 * 256 + kvh * 64;
    const float* CV = c.cache_v + (size_t)b * 2048 * 256 + kvh * 64;
    const float* spi = c.sproj + (size_t)(b * TS + i) * NCOL;
    float* ql = wl + 256;
#pragma unroll
    for (int gq = 0; gq < 4; ++gq) ql[gq * 64 + lane] = norm_rope_lane(spi[C_Q + (kvh * 4 + gq) * 64 + lane], c.q_norm_w, c.rope, TP + i, lane) * 0.125f;
    asm volatile("s_waitcnt lgkmcnt(0)" ::: "memory");
#pragma unroll 1
    for (int r = 0; r < 3; ++r) {
        const int e = lane + 64 * r; const int idx = 2048 + i - e * dil;
        const bool ok = e <= 128;
        const float* kp = (idx >= 2048 || !ok) ? wl + (ok ? idx - 2048 : 0) * 64 : CK + (size_t)idx * 256;
        f32x4 kr[16];
#pragma unroll
        for (int q4 = 0; q4 < 16; ++q4) kr[q4] = *(const f32x4*)(kp + 4 * q4);
#pragma unroll 1
        for (int gq = 0; gq < 4; ++gq) {
            float a = 0.f;
#pragma unroll
            for (int q4 = 0; q4 < 16; ++q4) { const f32x4 qv = *(const f32x4*)(ql + gq * 64 + 4 * q4); a += qv.x * kr[q4].x + qv.y * kr[q4].y + qv.z * kr[q4].z + qv.w * kr[q4].w; }
            sl[gq * 192 + e] = ok ? a : -INFINITY;
        }
    }
    asm volatile("s_waitcnt lgkmcnt(0)" ::: "memory");
    float mx[4];
#pragma unroll
    for (int gq = 0; gq < 4; ++gq) mx[gq] = fmaxf(fmaxf(sl[gq * 192 + lane], sl[gq * 192 + 64 + lane]), sl[gq * 192 + 128 + lane]);
    float lsum[4];
#pragma unroll
    for (int gq = 0; gq < 4; ++gq) { mx[gq] = wave_max(mx[gq]); lsum[gq] = 0.f; }
#pragma unroll 1
    for (int r = 0; r < 3; ++r) {
        const int e = lane + 64 * r;
#pragma unroll
        for (int gq = 0; gq < 4; ++gq) { const float sv = sl[gq * 192 + e]; const float pv = (sv == -INFINITY) ? 0.f : __expf(sv - mx[gq]); lsum[gq] += pv; sl[gq * 192 + e] = pv; }
    }
#pragma unroll
    for (int gq = 0; gq < 4; ++gq) lsum[gq] = wave_sum(lsum[gq]);
    asm volatile("s_waitcnt lgkmcnt(0)" ::: "memory");
    float o[4] = {0.f, 0.f, 0.f, 0.f};
    const int nnew = br == 0 ? i + 1 : 1;
#pragma unroll
    for (int e = 0; e < 4; ++e) {
        if (e < nnew) { const int j = i - e * dil; const float vv = j == 0 ? vnew[0] : j == 1 ? vnew[1] : j == 2 ? vnew[2] : vnew[3];
#pragma unroll
            for (int gq = 0; gq < 4; ++gq) o[gq] += sl[gq * 192 + e] * vv; }
    }
    asm volatile("s_waitcnt lgkmcnt(0)" ::: "memory");
    if (lane < 4) { for (int e = 0; e < nnew; ++e) sl[lane * 192 + e] = 0.f; }
    asm volatile("s_waitcnt lgkmcnt(0)" ::: "memory");
#pragma unroll 1
    for (int e0 = 0; e0 < 144; e0 += 16) {
        float vv[16];
#pragma unroll
        for (int u = 0; u < 16; ++u) { int idx = 2048 + i - (e0 + u) * dil; idx = idx > 2047 ? 2047 : (idx < 0 ? 0 : idx); vv[u] = __builtin_nontemporal_load(CV + (size_t)idx * 256 + lane); }
#pragma unroll
        for (int u = 0; u < 16; ++u) {
            if (e0 + u <= 128) {
#pragma unroll
                for (int gq = 0; gq < 4; ++gq) o[gq] += sl[gq * 192 + e0 + u] * vv[u];
            }
        }
    }
#pragma unroll
    for (int gq = 0; gq < 4; ++gq) {
        float* pp = c.spart + ((size_t)((b * TS + i) * 16 + kvh * 4 + gq) * 3 + br) * 68;
        pp[4 + lane] = o[gq];
        if (lane == 0) { pp[0] = mx[gq]; pp[1] = lsum[gq]; }
    }
}
constexpr int N_PA = BP * 4 * 32 * 4, N_SA = BS * TS * 4 * 3, N_PA_A = 512;
__device__ __forceinline__ void p2a_mixers(const Ctx& c, unsigned char* lds, int G, int flags) {
    const int tid = threadIdx.x, lane = tid & 63, wave = tid >> 6;
    for (int bi = blockIdx.x; bi < 256; bi += G) { if (!(flags & 1)) ssd_a_item(c, bi, lds); }
    for (int sj = G - 1 - (int)blockIdx.x; sj < 128; sj += G) { if (!(flags & 4)) ssd_item<true>(c, sj >> 4, sj & 15, lds); }
    __syncthreads();
    float* sl = (float*)(lds + wave * 8192); float* wl = sl + 4 * 192;
    const float bnd = 64.f * QSCALE * wave_max(fabsf(c.q_norm_w[lane])) * wave_max(fabsf(c.k_norm_w[lane]));
    if (flags & 2) return;
    for (int it = blockIdx.x * NW + wave; it < N_PA_A + N_SA; it += G * NW) {
        if (it < N_PA_A) { if (!(flags & 128)) attn_prompt_mfma(c, (N_PA - N_PA_A) + it, lane, bnd, (bf16x8*)(lds + 65536 + wave * 8192) + lane, (bf16_t*)(lds + wave * 8192)); }
        else if (!(flags & 64)) attn_sample_wave(c, it - N_PA_A, lane, sl, wl);
    }
}
__device__ __forceinline__ void sample_tail(const Ctx& c, int bidx, int nb);
__device__ __forceinline__ void p2b_mixers(const Ctx& c, unsigned char* lds, int G, int flags) {
    const int tid = threadIdx.x, lane = tid & 63, wave = tid >> 6;
    const int nchain = G >= 128 ? 64 : 0;
    if (nchain) { if ((int)blockIdx.x < nchain) { if (!(flags & 8)) ssd_chain_item(c, blockIdx.x >> 4, blockIdx.x & 15, lds); return; } }
    else for (int bi = blockIdx.x; bi < 64; bi += G) ssd_chain_item(c, bi >> 4, bi & 15, lds);
    if (flags & 2) return;
    { const int tb = G - 1 - (int)blockIdx.x, ntb = (G - nchain) < 64 ? (G - nchain) : 64; if (tb < ntb) sample_tail(c, tb, ntb); }
    const float bnd = 64.f * QSCALE * wave_max(fabsf(c.q_norm_w[lane])) * wave_max(fabsf(c.k_norm_w[lane]));
    for (int it = ((int)blockIdx.x - nchain) * NW + wave; it < N_PA - N_PA_A; it += (G - nchain) * NW)
        attn_prompt_mfma(c, it, lane, bnd, (bf16x8*)(lds + 65536 + wave * 8192) + lane, (bf16_t*)(lds + wave * 8192));
}
__device__ __forceinline__ void sample_tail(const Ctx& c, int bidx, int nb) {
    const int tid = threadIdx.x, lane = tid & 63, wave = tid >> 6;
    for (int i = bidx * NT + tid; i < MS * DM / 4; i += nb * NT) ((f32x4*)(c.out + O_YS))[i] = ((const f32x4*)c.x_sample)[i];
    for (int it = bidx * NW + wave; it < MS * 16; it += nb * NW) {
        const float* pp = c.spart + (size_t)it * 3 * 68;
        const float m0 = pp[0], m1 = pp[68], m2 = pp[136]; const float mx = fmaxf(m0, fmaxf(m1, m2));
        const float w0 = __expf(m0 - mx), w1 = __expf(m1 - mx), w2 = __expf(m2 - mx);
        const float den = pp[1] * w0 + pp[69] * w1 + pp[137] * w2, num = pp[4 + lane] * w0 + pp[72 + lane] * w1 + pp[140 + lane] * w2;
        const int row = it >> 4, h = it & 15;
        const float gt = silu_f(c.sproj[(size_t)row * NCOL + C_G + h * 64 + lane]);
        c.ymix[(size_t)(MP + row) * DM + 1024 + h * 64 + lane] = f2bf(num / den * gt);
    }
}

struct EpiOut {
    static constexpr bool PERM = false, AFTER_DRAIN = true, RESCALE = true;
    const float* x; float* out;
    __device__ __forceinline__ void operator()(const f32x4 (&acc)[2][2][4][2], const pg8::Unit& u, int wr, int wc, int fr, int fq) const {}
    __device__ __forceinline__ void rescale(f32x4 (&acc)[2][2][4][2], int t, int wr, int fr, LAS unsigned char* lds) const {
        const LAS float* F = (const LAS float*)(lds + pg8::STAGE_BYTES) + (t == 8 ? 0 : 256);
#pragma unroll
        for (int ai = 0; ai < 2; ++ai)
#pragma unroll
            for (int m = 0; m < 4; ++m) { const float f = F[ai * 128 + wr * 64 + m * 16 + fr];
#pragma unroll
                for (int bj = 0; bj < 2; ++bj)
#pragma unroll
                    for (int n = 0; n < 2; ++n) acc[ai][bj][m][n] = acc[ai][bj][m][n] * f; }
    }
    __device__ __forceinline__ void fused(f32x4 (&acc)[2][2][4][2], const pg8::Unit& u, int wr, int wc, int fr, int fq, LAS unsigned char* lds, int wid, int lane) const {
        LAS float* T = (LAS float*)lds;
#pragma unroll
        for (int ai = 0; ai < 2; ++ai)
#pragma unroll
            for (int m = 0; m < 4; ++m) {
                __builtin_amdgcn_s_barrier();
                LAS float* tp = T + (16 * wr + fr) * 260 + 64 * wc + 16 * fq;
#pragma unroll
                for (int bj = 0; bj < 2; ++bj)
#pragma unroll
                    for (int n = 0; n < 2; ++n) *(LAS f32x4*)(tp + 8 * bj + 4 * n) = acc[ai][bj][m][n];
                asm volatile("s_waitcnt lgkmcnt(0)" ::: "memory"); __builtin_amdgcn_s_barrier(); asm volatile("" ::: "memory");
#pragma unroll
                for (int k = 0; k < 4; ++k) {
                    const int tr = wid + 8 * k;
                    const size_t grow = (size_t)u.pm * 256 + ai * 128 + (tr >> 4) * 64 + m * 16 + (tr & 15);
                    const f32x4 v = *(LAS f32x4*)(T + tr * 260 + 4 * lane);
                    const size_t off = grow * DM + (size_t)u.pn * 256 + 4 * lane;
                    __builtin_nontemporal_store(__builtin_nontemporal_load((const f32x4*)(x + off)) + v, (f32x4*)(out + off));
                }
            }
    }
};
__device__ __forceinline__ void p3_sample(const Ctx& c, int G) {
    const int tid = threadIdx.x, lane = tid & 63, wave = tid >> 6, fr = lane & 15, fq = lane >> 4;
    for (int un = blockIdx.x * NW + wave; un < (DM / 16) * 16; un += G * NW) {
        const int nt = un & 127, ks = un >> 7;
        f32x4 acc[2] = {{0.f, 0.f, 0.f, 0.f}, {0.f, 0.f, 0.f, 0.f}};
        skinny_unit(c.ymix + (size_t)MP * DM, c.wt_out + (size_t)nt * 16 * DM, ks * 128, ks * 128 + 128, acc, fr, fq);
        const int lc = logical_of_phys_row(nt * 16 + fr);
#pragma unroll
        for (int mt = 0; mt < 2; ++mt)
#pragma unroll
            for (int r = 0; r < 4; ++r) {
                const int row = 16 * mt + 4 * fq + r; float f = 1.f;
                if (ks < 8) { const float* q = c.ssq + (size_t)(MP + row) * 16 + 8 * (ks >> 2); f = rsqrtf((((q[0] + q[1]) + (q[2] + q[3])) + ((q[4] + q[5]) + (q[6] + q[7]))) * (1.f / 512.f) + EPS); }
                atomicAdd(c.out + O_YS + (size_t)row * DM + lc, acc[mt][r] * f);
            }
    }
}

#define XB_TMO      128
#define XB_XCNT(j)  (256  + 64 * (j))
#define XB_XSUB(j)  (1280 + 64 * (j))
#define XB_XGEN(j)  (2304 + 64 * (j))
#define XB_TOP      3328
#define XB_TOPGEN   3392
#define XCD_BAR_WORDS 3456
#define XB_SPIN_CAP (1u << 18)

__device__ __forceinline__ unsigned xb_ld(unsigned* p)              { return __hip_atomic_load(p, __ATOMIC_RELAXED, __HIP_MEMORY_SCOPE_AGENT); }
__device__ __forceinline__ unsigned xb_add(unsigned* p, unsigned v) { return __hip_atomic_fetch_add(p, v, __ATOMIC_RELAXED, __HIP_MEMORY_SCOPE_AGENT); }
__device__ __forceinline__ unsigned xb_xcc_id() { return (unsigned)__builtin_amdgcn_s_getreg((3 << 11) | 20) & 0xFu; }
#define XB_SPIN(cond, bar) do { unsigned _sp = 0; while (cond) { __builtin_amdgcn_s_sleep(1); \
    if ((++_sp & 255u) == 0u) { if (xb_ld(&(bar)[XB_TMO])) break; if (_sp > XB_SPIN_CAP) { atomicAdd(&(bar)[XB_TMO], 1u); break; } } } } while (0)

struct XcdBarrier {
    unsigned* bar; unsigned x;
    volatile LAS unsigned* st;
};

__device__ __forceinline__ XcdBarrier xcd_barrier_post(unsigned* bar, volatile LAS unsigned* st) {
    XcdBarrier b; b.bar = bar; b.x = xb_xcc_id(); b.st = st;
    if (threadIdx.x == 0) (void)xb_add(&bar[XB_XCNT(b.x)], 1u);
    return b;
}
__device__ __forceinline__ void xcd_barrier_complete(unsigned* bar, unsigned x, unsigned& nloc, unsigned& nx) {
    const unsigned G = gridDim.x * gridDim.y * gridDim.z;
    unsigned sum, cnt, mine, sp = 0u;
    for (;;) {
        sum = 0u; cnt = 0u; mine = 0u;
#pragma unroll
        for (unsigned j = 0; j < 16; ++j) { const unsigned c = xb_ld(&bar[XB_XCNT(j)]); sum += c; cnt += (c > 0u) ? 1u : 0u; mine = (j == x) ? c : mine; }
        if (sum == G) break;
        __builtin_amdgcn_s_sleep(1);
        if ((++sp & 255u) == 0u) { if (xb_ld(&bar[XB_TMO])) break; if (sp > XB_SPIN_CAP) { atomicAdd(&bar[XB_TMO], 1u); break; } }
    }
    nloc = mine > 0u ? mine : 1u; nx = cnt > 0u ? cnt : 1u;
}

__device__ __forceinline__ void xcd_barrier(const XcdBarrier& b) {
    asm volatile("s_waitcnt vmcnt(0)" ::: "memory");
    __syncthreads();
    if (threadIdx.x == 0) {
        unsigned* bar = b.bar;
        __builtin_amdgcn_s_waitcnt(0);
        unsigned nloc = b.st[0], nx = b.st[1];
        if (nloc == 0u) { xcd_barrier_complete(bar, b.x, nloc, nx); b.st[0] = nloc; b.st[1] = nx; }
        const unsigned old = xb_add(&bar[XB_XSUB(b.x)], 1u);
        const unsigned gen = old / nloc;
        if (old + 1u == (gen + 1u) * nloc) {
            __builtin_amdgcn_fence(__ATOMIC_RELEASE, "agent");
            asm volatile("s_waitcnt vmcnt(0)" ::: "memory");
            const unsigned og = xb_add(&bar[XB_TOP], 1u);
            const unsigned tg = og / nx;
            if (og + 1u == (tg + 1u) * nx) xb_add(&bar[XB_TOPGEN], 1u);
            else XB_SPIN(xb_ld(&bar[XB_TOPGEN]) == tg, bar);
            __builtin_amdgcn_fence(__ATOMIC_ACQUIRE, "agent");
            xb_add(&bar[XB_XGEN(b.x)], 1u);
            asm volatile("s_waitcnt vmcnt(0)" ::: "memory");
        } else {
            XB_SPIN(xb_ld(&bar[XB_XGEN(b.x)]) == gen, bar);
            __builtin_amdgcn_fence(__ATOMIC_ACQUIRE, "agent");
            asm volatile("s_waitcnt vmcnt(0)" ::: "memory");
        }
    }
    __syncthreads();
}

struct Args { const float* in[17]; float* out; unsigned char* ws; int ph_lo, ph_hi, flags, pad; };
__global__ void __launch_bounds__(NT, 2) fwd_kernel(Args a) {
    extern __shared__ __attribute__((aligned(16))) unsigned char lds[];
    Ctx c;
    c.x_prompt = a.in[0]; c.x_sample = a.in[1]; c.cache_k = a.in[2]; c.cache_v = a.in[3]; c.state_conv = a.in[4]; c.state_ssm = a.in[5]; c.norm_w = a.in[6]; c.w_in = a.in[7];
    c.conv_w = a.in[8]; c.conv_b = a.in[9]; c.dt_bias = a.in[10]; c.a_log = a.in[11]; c.d_skip = a.in[12]; c.ssd_norm_w = a.in[13]; c.q_norm_w = a.in[14]; c.k_norm_w = a.in[15]; c.w_out = a.in[16];
    c.out = a.out; unsigned char* ws = a.ws;
    c.ctl = (unsigned*)(ws + WS_CTL); c.wt_in = (bf16_t*)(ws + WS_WTIN); c.wt_out = (bf16_t*)(ws + WS_WTOUT); c.xn = (bf16_t*)(ws + WS_XN); c.proj = (bf16_t*)(ws + WS_PROJ);
    c.dt = (float*)(ws + WS_DT); c.sproj = (float*)(ws + WS_SPROJ); c.rope = (float*)(ws + WS_ROPE); c.ymix = (bf16_t*)(ws + WS_YMIX); c.ssq = (float*)(ws + WS_SSQ); c.vt1 = (bf16_t*)(ws + WS_VT1); c.vt4 = (bf16_t*)(ws + WS_VT4); c.vt16 = (bf16_t*)(ws + WS_VT16); c.spart = (float*)(ws + WS_SPART); c.st = (float*)(ws + WS_ST); c.el = (float*)(ws + WS_EL); c.cd = (float*)(ws + WS_CD); c.yd = (float*)(ws + WS_YD); c.xcc = (bf16_t*)(ws + WS_XCC);
    const int G = gridDim.x;
    const int lo = a.ph_lo, hi = a.ph_hi;
    volatile LAS unsigned* bst = (volatile LAS unsigned*)((LAS unsigned char*)lds + (LDS_BYTES - 64));
    if (threadIdx.x == 0) { bst[0] = 0u; bst[1] = 0u; }
    __syncthreads();
    const XcdBarrier bar = xcd_barrier_post((unsigned*)(ws + WS_BAR), bst);
    if (lo < 0) cg::this_grid().sync();
#ifndef PH_MASK
#define PH_MASK 31
#endif
#define IN(k) (((PH_MASK >> (k)) & 1) && lo <= (k) && (k) < hi)
#define SEAM(k) do { if (IN(k) && IN((k) + 1)) xcd_barrier(bar); } while (0)
    if (IN(0)) p0_prologue(c, lds, G);
    SEAM(0);
    if (IN(1)) {
        pg8::Gemm g{c.xn, c.wt_in, MP, NBIG, DM}; pg8::StaticOrder S; S.init(MP, NBIG, G, (int)blockIdx.x);
        EpiIn E{c.proj, c.out, c.rope, c.q_norm_w, c.k_norm_w, c.vt1, c.vt4, c.vt16};
        pg8::gemm_phase<EpiIn, pg8::StaticOrder, true, true>((LAS unsigned char*)lds, g, S, E);
        const int half = G / 2;
        if ((int)blockIdx.x >= half) p1_extras(c, (int)blockIdx.x - half, G - half);
    }
    SEAM(1);
    if (IN(2)) p2a_mixers(c, lds, G, a.flags);
    SEAM(2);
    if (IN(3)) p2b_mixers(c, lds, G, a.flags);
    SEAM(3);
    if (IN(4)) {
        pg8::Gemm g{c.ymix, c.wt_out, MP, DM, DM}; pg8::StaticOrder S; S.init(MP, DM, G, (int)blockIdx.x);
        EpiOut E{c.x_prompt, c.out + O_YP};
        if (!(a.flags & 32)) p3_sample(c, G);
        {
            pg8::Unit u0;
            if (S.next(0, u0)) {
                float* F = (float*)(lds + pg8::STAGE_BYTES);
                for (int rI = threadIdx.x; rI < 256; rI += NT) {
                    const float* q = c.ssq + (size_t)(u0.pm * 256 + rI) * 16;
                    const f32x4 a0 = *(const f32x4*)q, a1 = *(const f32x4*)(q + 4), b0 = *(const f32x4*)(q + 8), b1 = *(const f32x4*)(q + 12);
                    const float s0 = ((a0.x + a0.y) + (a0.z + a0.w)) + ((a1.x + a1.y) + (a1.z + a1.w)), s1 = ((b0.x + b0.y) + (b0.z + b0.w)) + ((b1.x + b1.y) + (b1.z + b1.w));
                    const float r0 = rsqrtf(s0 * (1.f / 512.f) + EPS), r1 = rsqrtf(s1 * (1.f / 512.f) + EPS);
                    F[rI] = r0 / r1; F[256 + rI] = r1;
                }
            }
            __syncthreads();
        }
        pg8::gemm_phase<EpiOut, pg8::StaticOrder, false, true>((LAS unsigned char*)lds, g, S, E);
    }
}

extern "C" void kernel_launch(void* const* d_in, const int* in_sizes, int n_in, void* d_out, int out_size, void* d_ws, size_t ws_size, hipStream_t stream) {
    static int grid = 0;
    if (grid == 0) {
        if (n_in != 17 || (size_t)out_size != O_END || ws_size < WS_END) { fprintf(stderr, "kernel_launch: unexpected sizes n_in %d out %d ws %zu\n", n_in, out_size, ws_size); grid = -1; return; }
        int dev = 0, cus = 0, per_cu = 0;
        hipGetDevice(&dev); hipDeviceGetAttribute(&cus, hipDeviceAttributeMultiprocessorCount, dev);
        hipFuncSetAttribute((const void*)fwd_kernel, hipFuncAttributeMaxDynamicSharedMemorySize, LDS_BYTES);
        hipOccupancyMaxActiveBlocksPerMultiprocessor(&per_cu, (const void*)fwd_kernel, NT, LDS_BYTES);
        (void)hipGetLastError();
        if (per_cu < 1) { fprintf(stderr, "kernel_launch: occupancy query says %d blocks per CU\n", per_cu); per_cu = 1; }
        grid = cus;
    }
    if (grid < 0) return;
    hipMemsetAsync((char*)d_ws + WS_CTL, 0, WS_CTL_BYTES, stream);
    Args a{};
    for (int i = 0; i < 17; ++i) a.in[i] = (const float*)d_in[i];
    a.out = (float*)d_out; a.ws = (unsigned char*)d_ws;
#if N_LAUNCHES == 1
    a.ph_lo = 0; a.ph_hi = 5;
    void* args[] = {&a};
    hipError_t e = hipLaunchCooperativeKernel((const void*)fwd_kernel, dim3(grid), dim3(NT), args, LDS_BYTES, stream);
    if (e != hipSuccess) fprintf(stderr, "cooperative launch failed: %s (grid %d)\n", hipGetErrorString(e), grid);
#else
#ifndef PROBE_REP
#define PROBE_REP -1
#endif
#ifndef PROBE_FLAGS
#define PROBE_FLAGS 0
#endif
    for (int ph = 0; ph < 5; ++ph) {
        for (int rp = 0; rp < (ph == PROBE_REP ? 2 : 1); ++rp) {
            if (rp) hipMemsetAsync((char*)d_ws + WS_CTL, 0, WS_CTL_BYTES, stream);
            a.ph_lo = ph; a.ph_hi = ph + 1; a.flags = (ph == PROBE_REP && rp == 0) ? PROBE_FLAGS : 0;
            hipLaunchKernelGGL(fwd_kernel, dim3(grid), dim3(NT), LDS_BYTES, stream, a);
        }
    }
#endif
}
```

```cpp
#include <hip/hip_runtime.h>
#include <hip/hip_cooperative_groups.h>
#include <cstdio>
#include <cstdint>
namespace cg = cooperative_groups;
#ifndef N_LAUNCHES
#define N_LAUNCHES 1
#endif
namespace pg8 {
#define PG8_LAS __attribute__((address_space(3)))
typedef unsigned short bf16_t;
typedef short bf16x8 __attribute__((ext_vector_type(8)));
typedef float f32x4 __attribute__((ext_vector_type(4)));
typedef unsigned u32x4 __attribute__((ext_vector_type(4)));
constexpr int BM = 256, BK = 64, HALF = 128, HTB = HALF * BK * 2  , STAGE_BYTES = 8 * HTB, NXCD = 8, WGM = 8;

__host__ __device__ __forceinline__ int lds_byte(int r, int c) { const int st = (r >> 4) * 2 + (c >> 5), rr = r & 15, cc = c & 31, ob = rr * 64 + cc * 2; return st * 1024 + (ob ^ (((ob >> 9) & 1) << 5)); }
__host__ __device__ __forceinline__ void stage_rc(int b, int& R, int& C) { const int st = b / 1024, sb = b % 1024, swz = sb ^ (((sb >> 9) & 1) << 5); R = (st >> 1) * 16 + swz / 64; C = (st & 1) * 32 + (swz % 64) / 2; }
__host__ __device__ __forceinline__ int perm32(int rho) { const int n = rho >> 4, i = rho & 15; return 8 * (i >> 2) + 4 * n + (i & 3); }

struct Unit { int pm, pn; };
struct Gemm { const bf16_t* A; const bf16_t* Bt; int M, N, K; };

struct StaticOrder {
    int nM, nN, nwg, G, c;
    __host__ __device__ void init(int M, int N, int G_, int c_) { nM = M / BM; nN = N / BM; nwg = nM * nN; G = G_; c = c_; }
    __host__ __device__ bool next(int i, Unit& u) const {
        const long L = (long)i * G + c; if (L >= nwg) return false;
        int wgid = (int)L; { const int q = nwg / NXCD, r = nwg % NXCD, xcd = wgid % NXCD, off = wgid / NXCD; wgid = (xcd < r ? xcd * (q + 1) : r * (q + 1) + (xcd - r) * q) + off; }
        const int nig = WGM * nN, gid = wgid / nig, fm = gid * WGM, gsz = (nM - fm) < WGM ? (nM - fm) : WGM;
        u.pm = fm + ((wgid % nig) % gsz); u.pn = (wgid % nig) / gsz; return true;
    }
    __device__ __forceinline__ void a_ready(const Unit&) const {}
    __device__ __forceinline__ void done(const Unit&) const {}
};
__device__ __forceinline__ unsigned cvt_pk_bf16(float lo, float hi) { unsigned r; asm volatile("v_cvt_pk_bf16_f32 %0, %1, %2" : "=v"(r) : "v"(lo), "v"(hi)); return r; }
typedef float f32x2 __attribute__((ext_vector_type(2)));
template <class Epi, class Sched, bool ALIGN_EPI = false, bool SP2 = false>
__device__ __forceinline__ void gemm_phase(PG8_LAS unsigned char* lds, const Gemm g, const Sched& S, const Epi& E) {
    const int tid = threadIdx.x, wid = __builtin_amdgcn_readfirstlane(tid >> 6), lane = tid & 63, wr = wid >> 2, wc = wid & 3, fr = lane & 15, fq = lane >> 4;
    const int K = g.K, nt = K / BK;
    unsigned voffA[2], voffB[2];
#pragma unroll
    for (int i = 0; i < 2; ++i) { int R, C; stage_rc(tid * 16 + i * 8192, R, C); const int Rb = Epi::PERM ? ((R & ~31) + perm32(R & 31)) : R;
        voffA[i] = (unsigned)(R * K + C) * 2u; voffB[i] = (unsigned)(Rb * K + C) * 2u; }
    const size_t kstep = (size_t)(BK * 2);
    const size_t hstep = (size_t)HALF * K * 2;
    const size_t tstep = 2 * hstep;
    const unsigned ldsw = (unsigned)wid * 1024u;
    const int aoff = lds_byte(wr * 64 + fr, fq * 8), boff = lds_byte(wc * 32 + fr, fq * 8);
#define PG8_SA(b, h) (((b) * 2 + (h)) * HTB)
#define PG8_SB(b, h) ((4 + (b) * 2 + (h)) * HTB)
#define PG8_STAGE(bufoff, gbase, voff) do { _Pragma("unroll") for (int _i = 0; _i < 2; ++_i) \
        __builtin_amdgcn_global_load_lds((const unsigned*)((const char*)(gbase) + (voff)[_i]), (PG8_LAS unsigned*)(lds + (bufoff) + ldsw + _i * 8192), 16, 0, 0); } while (0)
#define PG8_LDA(dst, b, h) do { _Pragma("unroll") for (int m = 0; m < 4; ++m) _Pragma("unroll") for (int k = 0; k < 2; ++k) dst[m][k] = *(const PG8_LAS bf16x8*)(lds + PG8_SA(b, h) + aoff + m * 2048 + k * 1024); } while (0)
#define PG8_LDB(dst, b, h) do { _Pragma("unroll") for (int n = 0; n < 2; ++n) _Pragma("unroll") for (int k = 0; k < 2; ++k) dst[n][k] = *(const PG8_LAS bf16x8*)(lds + PG8_SB(b, h) + boff + n * 2048 + k * 1024); } while (0)
#define PG8_MMA(ai, bj, At, Bt) do { __builtin_amdgcn_s_setprio(1); _Pragma("unroll") for (int m = 0; m < 4; ++m) _Pragma("unroll") for (int n = 0; n < 2; ++n) _Pragma("unroll") for (int k = 0; k < 2; ++k) \
        acc[ai][bj][m][n] = __builtin_amdgcn_mfma_f32_16x16x32_bf16(Bt[n][k], At[m][k], acc[ai][bj][m][n], 0, 0, 0); __builtin_amdgcn_s_setprio(0); } while (0)
#define PG8_WAIT_V(n) asm volatile("s_waitcnt vmcnt(" #n ")" ::: "memory")
#define PG8_WAIT_L(n) asm volatile("s_waitcnt lgkmcnt(" #n ")" ::: "memory")
#define PG8_BAR __builtin_amdgcn_s_barrier()
#define PG8_SCHED __builtin_amdgcn_sched_barrier(0)
    Unit cur, nxt; int ui = 0;
    if (!S.next(0, cur)) return;
    f32x4 acc[2][2][4][2];
#pragma unroll
    for (int a = 0; a < 2; ++a)
#pragma unroll
        for (int b = 0; b < 2; ++b)
#pragma unroll
            for (int m = 0; m < 4; ++m)
#pragma unroll
                for (int n = 0; n < 2; ++n) acc[a][b][m][n] = (f32x4){0.f, 0.f, 0.f, 0.f};
    bf16x8 At[4][2], B0[2][2], B1[2][2];
    const char* cA = (const char*)g.A + (size_t)cur.pm * tstep; const char* cB = (const char*)g.Bt + (size_t)cur.pn * tstep;
    S.a_ready(cur);
    if constexpr (SP2) {
        PG8_STAGE(PG8_SB(0, 0), cB, voffB); PG8_STAGE(PG8_SB(0, 1), cB + hstep, voffB); PG8_STAGE(PG8_SA(0, 0), cA, voffA); PG8_STAGE(PG8_SA(0, 1), cA + hstep, voffA);
        if (wr == 1) PG8_BAR;
        PG8_WAIT_V(2); PG8_BAR;
        PG8_STAGE(PG8_SB(1, 0), cB + kstep, voffB); PG8_STAGE(PG8_SA(1, 0), cA + kstep, voffA); PG8_STAGE(PG8_SB(1, 1), cB + hstep + kstep, voffB);
        PG8_WAIT_V(6); PG8_BAR;
    } else {
        PG8_STAGE(PG8_SB(0, 0), cB, voffB); PG8_STAGE(PG8_SA(0, 0), cA, voffA); PG8_STAGE(PG8_SB(0, 1), cB + hstep, voffB); PG8_STAGE(PG8_SA(0, 1), cA + hstep, voffA);
        if (wr == 1) PG8_BAR;
        PG8_WAIT_V(4); PG8_BAR;
        PG8_STAGE(PG8_SB(1, 0), cB + kstep, voffB); PG8_STAGE(PG8_SA(1, 0), cA + kstep, voffA); PG8_STAGE(PG8_SB(1, 1), cB + hstep + kstep, voffB);
        PG8_WAIT_V(6); PG8_BAR;
    }
    for (;;) {
        const bool has_next = S.next(ui + 1, nxt);
        const char* nA = has_next ? (const char*)g.A + (size_t)nxt.pm * tstep : cA; const char* nB = has_next ? (const char*)g.Bt + (size_t)nxt.pn * tstep : cB;
        for (int t = 0; t < nt; t += 2) {
            if constexpr (Epi::RESCALE) { if (t == 8 || t == 16) E.rescale(acc, t, wr, fr, lds); }
            const bool last = (t == nt - 2);
            const char* a1 = cA + (size_t)(t + 1) * kstep;
            const char* a2 = last ? nA : cA + (size_t)(t + 2) * kstep; const char* b2 = last ? nB : cB + (size_t)(t + 2) * kstep;
            const char* a3 = a2 + kstep; const char* b3 = b2 + kstep;
            if (last && has_next) S.a_ready(nxt);
            if constexpr (SP2) {
            PG8_LDB(B0, 0, 0); PG8_LDB(B1, 0, 1); PG8_SCHED; PG8_LDA(At, 0, 0); PG8_STAGE(PG8_SA(1, 1), a1 + hstep, voffA);
            PG8_WAIT_V(8); PG8_WAIT_L(0); PG8_BAR; PG8_MMA(0, 0, At, B0); PG8_MMA(0, 1, At, B1); PG8_BAR; PG8_SCHED;
            PG8_LDA(At, 0, 1); PG8_STAGE(PG8_SB(0, 0), b2, voffB); PG8_STAGE(PG8_SB(0, 1), b2 + hstep, voffB); PG8_STAGE(PG8_SA(0, 0), a2, voffA);
            PG8_WAIT_V(8); PG8_WAIT_L(0); PG8_BAR; PG8_MMA(1, 0, At, B0); PG8_MMA(1, 1, At, B1); PG8_BAR; PG8_SCHED;
            PG8_LDB(B0, 1, 0); PG8_LDB(B1, 1, 1); PG8_SCHED; PG8_LDA(At, 1, 0); PG8_STAGE(PG8_SA(0, 1), a2 + hstep, voffA);
            PG8_WAIT_V(8); PG8_WAIT_L(0); PG8_BAR; PG8_MMA(0, 0, At, B0); PG8_MMA(0, 1, At, B1); PG8_BAR; PG8_SCHED;
            PG8_LDA(At, 1, 1); PG8_STAGE(PG8_SB(1, 0), b3, voffB); PG8_STAGE(PG8_SB(1, 1), b3 + hstep, voffB); PG8_STAGE(PG8_SA(1, 0), a3, voffA);
            PG8_WAIT_V(8); PG8_WAIT_L(0); PG8_BAR; PG8_MMA(1, 0, At, B0); PG8_MMA(1, 1, At, B1); PG8_BAR; PG8_SCHED;
            } else {
            PG8_LDB(B0, 0, 0); PG8_SCHED; PG8_LDA(At, 0, 0); PG8_STAGE(PG8_SA(1, 1), a1 + hstep, voffA);
            PG8_WAIT_L(8); PG8_BAR; PG8_WAIT_L(0); PG8_MMA(0, 0, At, B0); PG8_BAR; PG8_SCHED;
            PG8_LDB(B1, 0, 1); PG8_STAGE(PG8_SB(0, 0), b2, voffB);
            PG8_BAR; PG8_WAIT_L(0); PG8_MMA(0, 1, At, B1); PG8_BAR;
            PG8_LDA(At, 0, 1); PG8_STAGE(PG8_SA(0, 0), a2, voffA);
            PG8_BAR; PG8_WAIT_L(0); PG8_MMA(1, 0, At, B0); PG8_BAR; PG8_SCHED;
            PG8_STAGE(PG8_SB(0, 1), b2 + hstep, voffB);
            PG8_WAIT_V(6); PG8_BAR; PG8_MMA(1, 1, At, B1); PG8_BAR;
            PG8_LDB(B0, 1, 0); PG8_SCHED; PG8_LDA(At, 1, 0); PG8_STAGE(PG8_SA(0, 1), a2 + hstep, voffA);
            PG8_WAIT_L(8); PG8_BAR; PG8_WAIT_L(0); PG8_MMA(0, 0, At, B0); PG8_BAR; PG8_SCHED;
            PG8_LDB(B1, 1, 1); PG8_STAGE(PG8_SB(1, 0), b3, voffB);
            PG8_BAR; PG8_WAIT_L(0); PG8_MMA(0, 1, At, B1); PG8_BAR;
            PG8_LDA(At, 1, 1); PG8_STAGE(PG8_SA(1, 0), a3, voffA);
            PG8_BAR; PG8_WAIT_L(0); PG8_MMA(1, 0, At, B0); PG8_BAR; PG8_SCHED;
            PG8_STAGE(PG8_SB(1, 1), b3 + hstep, voffB);
            PG8_WAIT_V(6); PG8_BAR; PG8_MMA(1, 1, At, B1); PG8_BAR;
            }
        }
        if constexpr (ALIGN_EPI) { if (wr == 0) PG8_BAR; }
        if constexpr (!Epi::AFTER_DRAIN) { E(acc, cur, wr, wc, fr, fq); S.done(cur); }
        if (!has_next) break;
#pragma unroll
        for (int a = 0; a < 2; ++a)
#pragma unroll
            for (int b = 0; b < 2; ++b)
#pragma unroll
                for (int m = 0; m < 4; ++m)
#pragma unroll
                    for (int n = 0; n < 2; ++n) acc[a][b][m][n] = (f32x4){0.f, 0.f, 0.f, 0.f};
        cur = nxt; cA = nA; cB = nB; ++ui;
        if constexpr (ALIGN_EPI) { if (wr == 1) PG8_BAR; }
    }
    PG8_WAIT_V(0);
    if constexpr (!ALIGN_EPI) { if (wr == 0) PG8_BAR; }
    PG8_BAR;
    if constexpr (Epi::AFTER_DRAIN) { E.fused(acc, cur, wr, wc, fr, fq, lds, wid, lane); S.done(cur); }
#undef PG8_SA
#undef PG8_SB
#undef PG8_STAGE
#undef PG8_LDA
#undef PG8_LDB
#undef PG8_MMA
#undef PG8_WAIT_V
#undef PG8_WAIT_L
#undef PG8_BAR
#undef PG8_SCHED
}
}

using pg8::bf16_t; using pg8::bf16x8; using pg8::f32x4; using pg8::u32x4;
#define LAS __attribute__((address_space(3)))
constexpr int DM = 2048, TP = 2048, BP = 4, MP = BP * TP, BS = 8, TS = 4, MS = BS * TS;
constexpr int NCOL = 5136, NBIG = 5120;
constexpr int C_Z = 0, C_XBC = 1024, C_Q = 2560, C_K = 3584, C_V = 3840, C_G = 4096, C_DT = 5120;
constexpr int CONVD = 1536;
constexpr float EPS = 1e-6f;
constexpr float LOG2E = 1.4426950408889634f, QSCALE = 0.125f * LOG2E;
constexpr size_t WS_CTL = 0;
constexpr size_t WS_BAR = 16384;
constexpr size_t WS_CTL_BYTES = 32768;
constexpr size_t WS_WTIN = WS_CTL_BYTES;
constexpr size_t WS_WTOUT = WS_WTIN + (size_t)NCOL * DM * 2;
constexpr size_t WS_XN = WS_WTOUT + (size_t)DM * DM * 2;
constexpr size_t WS_PROJ = WS_XN + (size_t)(MP + MS) * DM * 2;
constexpr size_t WS_DT = WS_PROJ + (size_t)MP * NBIG * 2;
constexpr size_t WS_SPROJ = WS_DT + (size_t)MP * 16 * 4;
constexpr size_t WS_ROPE = WS_SPROJ + (size_t)MS * NCOL * 4;
constexpr size_t WS_YMIX = WS_ROPE + (size_t)(TP + TS) * 16 * 4;
constexpr size_t WS_SSQ = WS_YMIX + (size_t)(MP + MS) * DM * 2;
constexpr size_t WS_VT4 = WS_SSQ + (size_t)(MP + MS) * 16 * 4;
constexpr size_t WS_VT1 = WS_VT4 + (size_t)MP * 256 * 2;
constexpr size_t WS_VT16 = WS_VT1 + (size_t)MP * 256 * 2;
constexpr size_t WS_SPART = WS_VT16 + (size_t)MP * 256 * 2 + 4096;
constexpr size_t WS_ST = WS_SPART + (size_t)MS * 16 * 3 * 68 * 4;
constexpr size_t WS_XCC = WS_ST + (size_t)BP * 16 * 16 * 8192 * 4;
constexpr size_t WS_EL = WS_XCC + (size_t)MP * 256 * 2;
constexpr size_t WS_CD = WS_EL + (size_t)MP * 16 * 4;
constexpr size_t WS_END = WS_CD + 4096;
constexpr size_t WS_YD = WS_XN;
constexpr size_t O_YP = 0;
constexpr size_t O_YS = O_YP + (size_t)MP * DM;
constexpr size_t O_KP = O_YS + (size_t)MS * DM;
constexpr size_t O_VP = O_KP + (size_t)MP * 256;
constexpr size_t O_CP = O_VP + (size_t)MP * 256;
constexpr size_t O_HP = O_CP + (size_t)BP * 3 * CONVD;
constexpr size_t O_KS = O_HP + (size_t)BP * 16 * 64 * 128;
constexpr size_t O_VS = O_KS + (size_t)BS * 2048 * 256;
constexpr size_t O_CS = O_VS + (size_t)BS * 2048 * 256;
constexpr size_t O_HS = O_CS + (size_t)BS * 3 * CONVD;
constexpr size_t O_END = O_HS + (size_t)BS * 16 * 64 * 128;

constexpr int NT = 512, NW = 8;
constexpr int LDS_BYTES = 147456;

struct Ctx {
    const float *x_prompt, *x_sample, *cache_k, *cache_v, *state_conv, *state_ssm, *norm_w, *w_in, *conv_w, *conv_b, *dt_bias, *a_log, *d_skip, *ssd_norm_w, *q_norm_w, *k_norm_w, *w_out;
    float* out; unsigned* ctl;
    bf16_t *wt_in, *wt_out, *xn, *proj, *ymix, *vt1, *vt4, *vt16; float *dt, *sproj, *rope, *ssq, *spart, *st, *el, *cd, *yd; bf16_t* xcc;
};

__device__ __forceinline__ unsigned pk2(float lo, float hi) { return pg8::cvt_pk_bf16(lo, hi); }
__device__ __forceinline__ float bf_lo(unsigned u) { return __uint_as_float(u << 16); }
__device__ __forceinline__ float bf_hi(unsigned u) { return __uint_as_float(u & 0xffff0000u); }
__device__ __forceinline__ float bf2f(bf16_t h) { return __uint_as_float((unsigned)h << 16); }
__device__ __forceinline__ bf16_t f2bf(float f) { return (bf16_t)(pk2(f, 0.f) & 0xffffu); }
__device__ __forceinline__ float silu_f(float v) { return v * __builtin_amdgcn_rcpf(1.f + __expf(-v)); }
__device__ __forceinline__ float softplus_f(float v) { return v > 20.f ? v : log1pf(__expf(v)); }
__device__ __forceinline__ float wave_sum(float v) {
#pragma unroll
    for (int o = 32; o >= 1; o >>= 1) v += __shfl_xor(v, o);
    return v;
}
__device__ __forceinline__ float wave_max(float v) {
#pragma unroll
    for (int o = 32; o >= 1; o >>= 1) v = fmaxf(v, __shfl_xor(v, o));
    return v;
}
__device__ __forceinline__ int tileperm(int l) { const int wc = l >> 6, fq = (l >> 4) & 3, bj = (l >> 3) & 1, n = (l >> 2) & 1, e = l & 3; return 128 * bj + 32 * wc + 16 * n + 4 * fq + e; }
__device__ __forceinline__ int tileperm_inv(int p) { const int bj = p >> 7, wc = (p >> 5) & 3, n = (p >> 4) & 1, fq = (p >> 2) & 3, e = p & 3; return 64 * wc + 16 * fq + 8 * bj + 4 * n + e; }
__device__ __forceinline__ int logical_col_in(int s) { return s < 2560 ? s : (s < 2576 ? NBIG + (s - 2560) : s - 16); }
__device__ __forceinline__ int phys_row_of_logical(int c) { return c >= NBIG ? c : (c & ~255) + tileperm(c & 255); }
__device__ __forceinline__ int logical_of_phys_row(int p) { return p >= NBIG ? p : (p & ~255) + tileperm_inv(p & 255); }

template <bool IS_IN>
__device__ __forceinline__ void p0_transpose_item(const float* W, int N, const float* kscale, int kscale_n, bf16_t* WT, float* scr, int item, int lane) {
    const int nblk = (N + 63) / 64, kb = item / nblk, nb = item % nblk, k0 = 64 * kb, n0 = 64 * nb;
    const int colr = n0 + lane;
#pragma unroll
    for (int i = 0; i < 64; ++i) {
        float v = 0.f;
        if (colr < N) v = __builtin_nontemporal_load(W + (size_t)(k0 + i) * N + colr);
        const float sc = (k0 + i < kscale_n) ? kscale[k0 + i] : 1.f;
        scr[i * 65 + lane] = v * sc;
    }
    asm volatile("s_waitcnt lgkmcnt(0)" ::: "memory");
    const int c = lane & 7;
#pragma unroll
    for (int j = 0; j < 8; ++j) {
        const int n = (lane >> 3) + 8 * j; const int col = n0 + n;
        if (col < N) {
            const int row = IS_IN ? phys_row_of_logical(logical_col_in(col)) : phys_row_of_logical(col);
            const float* sp = scr + (8 * c) * 65 + n;
            u32x4 o; o.x = pk2(sp[0 * 65], sp[1 * 65]); o.y = pk2(sp[2 * 65], sp[3 * 65]); o.z = pk2(sp[4 * 65], sp[5 * 65]); o.w = pk2(sp[6 * 65], sp[7 * 65]);
            *(u32x4*)(WT + (size_t)row * DM + k0 + 8 * c) = o;
        }
    }
    asm volatile("s_waitcnt lgkmcnt(0)" ::: "memory");
}
__device__ __forceinline__ void rms_row_to_bf16(const float* xrow, bf16_t* orow, int lane) {
    const f32x4* xr = (const f32x4*)xrow + lane;
    f32x4 v[8]; float s = 0.f;
#pragma unroll
    for (int j = 0; j < 8; ++j) { v[j] = __builtin_nontemporal_load(xr + 64 * j); s += (v[j].x * v[j].x + v[j].y * v[j].y) + (v[j].z * v[j].z + v[j].w * v[j].w); }
    const float rstd = rsqrtf(wave_sum(s) * (1.f / DM) + EPS);
    unsigned long long* o8 = (unsigned long long*)orow + lane;
#pragma unroll
    for (int j = 0; j < 8; ++j) o8[64 * j] = (unsigned long long)pk2(v[j].x * rstd, v[j].y * rstd) | ((unsigned long long)pk2(v[j].z * rstd, v[j].w * rstd) << 32);
}
__device__ __forceinline__ float rope_inv(int i) {
    return i == 0 ? 1.0f : i == 1 ? 0.1939227432012558f : i == 2 ? 0.03760603070259094f : i == 3 ? 0.007292664609849453f : i == 4 ? 0.0014142135623842478f
         : i == 5 ? 0.00027424818836152554f : i == 6 ? 5.3182957344688475e-05f : 1.0313385246263351e-05f;
}
__device__ __forceinline__ void p0_prologue(const Ctx& c, unsigned char* lds, int G) {
    const int tid = threadIdx.x, lane = tid & 63, wave = tid >> 6;
    float* scr = (float*)(lds + wave * 16896);
    const int gw = blockIdx.x * NW + wave, NGW = G * NW;
    constexpr int I_IN = (DM / 64) * ((NCOL + 63) / 64), I_OUT = (DM / 64) * (DM / 64);
    for (int it = gw; it < I_IN + I_OUT; it += NGW) {
        if (it < I_IN) p0_transpose_item<true>(c.w_in, NCOL, c.norm_w, DM, c.wt_in, scr, it, lane);
        else p0_transpose_item<false>(c.w_out, DM, c.ssd_norm_w, 1024, c.wt_out, scr, it - I_IN, lane);
    }
    for (int m = gw; m < MP + MS; m += 2 * NGW) {
        const int m2 = m + NGW;
        const float* s0 = m < MP ? c.x_prompt + (size_t)m * DM : c.x_sample + (size_t)(m - MP) * DM;
        if (m2 < MP + MS) {
            const float* s1 = m2 < MP ? c.x_prompt + (size_t)m2 * DM : c.x_sample + (size_t)(m2 - MP) * DM;
            const f32x4* x0 = (const f32x4*)s0 + lane; const f32x4* x1 = (const f32x4*)s1 + lane;
            f32x4 v0[8], v1[8]; float q0 = 0.f, q1 = 0.f;
#pragma unroll
            for (int j = 0; j < 8; ++j) { v0[j] = x0[64 * j]; v1[j] = x1[64 * j]; }
#pragma unroll
            for (int j = 0; j < 8; ++j) { q0 += (v0[j].x * v0[j].x + v0[j].y * v0[j].y) + (v0[j].z * v0[j].z + v0[j].w * v0[j].w); q1 += (v1[j].x * v1[j].x + v1[j].y * v1[j].y) + (v1[j].z * v1[j].z + v1[j].w * v1[j].w); }
            const float r0 = rsqrtf(wave_sum(q0) * (1.f / DM) + EPS), r1 = rsqrtf(wave_sum(q1) * (1.f / DM) + EPS);
            unsigned long long* o0 = (unsigned long long*)(c.xn + (size_t)m * DM) + lane; unsigned long long* o1 = (unsigned long long*)(c.xn + (size_t)m2 * DM) + lane;
#pragma unroll
            for (int j = 0; j < 8; ++j) { o0[64 * j] = (unsigned long long)pk2(v0[j].x * r0, v0[j].y * r0) | ((unsigned long long)pk2(v0[j].z * r0, v0[j].w * r0) << 32);
                o1[64 * j] = (unsigned long long)pk2(v1[j].x * r1, v1[j].y * r1) | ((unsigned long long)pk2(v1[j].z * r1, v1[j].w * r1) << 32); }
        } else rms_row_to_bf16(s0, c.xn + (size_t)m * DM, lane);
    }
    for (int e = blockIdx.x * NT + tid; e < (TP + TS) * 8; e += G * NT) {
        const int pi = e >> 3, i = e & 7; const int pos = pi < TP ? pi : 16384 + (pi - TP);
        const float ang = (float)pos * rope_inv(i);
        float sn, cs; sincosf(ang, &sn, &cs);
        c.rope[2 * e] = cs; c.rope[2 * e + 1] = sn;
    }
}

struct EpiIn {
    static constexpr bool PERM = false, AFTER_DRAIN = false, RESCALE = false;
    bf16_t* proj; float* out; const float* rope; const float* qnw; const float* knw; bf16_t *vt1, *vt4, *vt16;
    __device__ __forceinline__ void operator()(const f32x4 (&acc)[2][2][4][2], const pg8::Unit& u, int wr, int wc, int fr, int fq) const {
        const int pn = u.pn;
        const int type = pn < 4 ? 0 : pn < 10 ? 1 : pn < 14 ? 2 : pn == 14 ? 3 : pn == 15 ? 4 : 5;
        const int col0 = pn * 256 + 64 * wc + 16 * fq;
#pragma unroll
        for (int ai = 0; ai < 2; ++ai)
#pragma unroll
            for (int m = 0; m < 4; ++m) {
                const int row = u.pm * 256 + ai * 128 + wr * 64 + m * 16 + fr;
                float v[16];
#pragma unroll
                for (int bj = 0; bj < 2; ++bj)
#pragma unroll
                    for (int n = 0; n < 2; ++n)
#pragma unroll
                        for (int e = 0; e < 4; ++e) v[8 * bj + 4 * n + e] = acc[ai][bj][m][n][e];
                if (type == 2 || type == 3) {
                    float ss = 0.f;
#pragma unroll
                    for (int i = 0; i < 16; ++i) ss += v[i] * v[i];
                    ss += __shfl_xor(ss, 16); ss += __shfl_xor(ss, 32);
                    const float rstd = rsqrtf(ss * (1.f / 64.f) + EPS);
                    const float* nw = (type == 2 ? qnw : knw) + 16 * fq;
#pragma unroll
                    for (int i = 0; i < 16; ++i) v[i] *= rstd * nw[i];
                    if (fq == 0) {
                        const float* rp = rope + (size_t)(row & (TP - 1)) * 16;
#pragma unroll
                        for (int i = 0; i < 8; ++i) { const float cs = rp[2 * i], sn = rp[2 * i + 1]; const float x1 = v[i], x2 = v[i + 8]; v[i] = x1 * cs - x2 * sn; v[i + 8] = x2 * cs + x1 * sn; }
                    }
                    if (type == 2) {
#pragma unroll
                        for (int i = 0; i < 16; ++i) v[i] *= QSCALE;
                    }
                } else if (type == 5 || type == 0) {
#pragma unroll
                    for (int i = 0; i < 16; ++i) v[i] = silu_f(v[i]);
                }
                if (type == 3 || type == 4) {
                    float* o = out + (type == 3 ? O_KP : O_VP) + (size_t)row * 256 + 64 * wc + 16 * fq;
#pragma unroll
                    for (int i = 0; i < 4; ++i) *(f32x4*)(o + 4 * i) = (f32x4){v[4 * i], v[4 * i + 1], v[4 * i + 2], v[4 * i + 3]};
                }
                if (type == 1) {
                    const int t = row & (TP - 1);
                    if (t >= TP - 3) {
                        float* o = out + O_CP + (size_t)((row >> 11) * 3 + (t - (TP - 3))) * CONVD + (col0 - C_XBC);
#pragma unroll
                        for (int i = 0; i < 4; ++i) *(f32x4*)(o + 4 * i) = (f32x4){v[4 * i], v[4 * i + 1], v[4 * i + 2], v[4 * i + 3]};
                    }
                }
                u32x4 w0, w1;
                w0.x = pk2(v[0], v[1]); w0.y = pk2(v[2], v[3]); w0.z = pk2(v[4], v[5]); w0.w = pk2(v[6], v[7]);
                w1.x = pk2(v[8], v[9]); w1.y = pk2(v[10], v[11]); w1.z = pk2(v[12], v[13]); w1.w = pk2(v[14], v[15]);
                bf16_t* dst = proj + (size_t)row * NBIG + col0;
                *(u32x4*)dst = w0; *(u32x4*)(dst + 8) = w1;
            }
    }
};

__device__ __forceinline__ void skinny_unit(const bf16_t* X, const bf16_t* W, int kbeg, int kend, f32x4 (&acc)[2], int fr, int fq) {
    const bf16_t* xa = X + (size_t)fr * DM + 8 * fq; const bf16_t* xb = xa + 16 * DM; const bf16_t* wp = W + (size_t)fr * DM + 8 * fq;
#pragma unroll 8
    for (int k0 = kbeg; k0 < kend; k0 += 32) {
        const bf16x8 a0 = *(const bf16x8*)(xa + k0), a1 = *(const bf16x8*)(xb + k0), b = *(const bf16x8*)(wp + k0);
        acc[0] = __builtin_amdgcn_mfma_f32_16x16x32_bf16(a0, b, acc[0], 0, 0, 0);
        acc[1] = __builtin_amdgcn_mfma_f32_16x16x32_bf16(a1, b, acc[1], 0, 0, 0);
    }
}
__device__ __forceinline__ void p1_extras(const Ctx& c, int eb, int neb) {
    const int tid = threadIdx.x, lane = tid & 63, wave = tid >> 6, fr = lane & 15, fq = lane >> 4;
    constexpr int U_S = NCOL / 16, U_DT = MP / 32;
    for (int un = eb * NW + wave; un < U_S + U_DT; un += neb * NW) {
        f32x4 acc[2] = {{0.f, 0.f, 0.f, 0.f}, {0.f, 0.f, 0.f, 0.f}};
        if (un < U_S) {
            skinny_unit(c.xn + (size_t)MP * DM, c.wt_in + (size_t)un * 16 * DM, 0, DM, acc, fr, fq);
            const int lc = logical_of_phys_row(un * 16 + fr);
#pragma unroll
            for (int mt = 0; mt < 2; ++mt)
#pragma unroll
                for (int r = 0; r < 4; ++r) c.sproj[(size_t)(16 * mt + 4 * fq + r) * NCOL + lc] = acc[mt][r];
        } else {
            const int r0 = (un - U_S) * 32;
            skinny_unit(c.xn + (size_t)r0 * DM, c.wt_in + (size_t)NBIG * DM, 0, DM, acc, fr, fq);
            const float bias = c.dt_bias[fr];
#pragma unroll
            for (int mt = 0; mt < 2; ++mt)
#pragma unroll
                for (int r = 0; r < 4; ++r) c.dt[(size_t)(r0 + 16 * mt + 4 * fq + r) * 16 + fr] = softplus_f(acc[mt][r] + bias);
        }
    }
    constexpr int PER_B = 2044 * 256 / 4;
    constexpr int NCP = 2 * BS * PER_B;
    for (int i0 = eb * NT + tid; i0 < NCP; i0 += 8 * neb * NT) {
        f32x4 v[8];
#pragma unroll
        for (int u = 0; u < 8; ++u) { const int i = i0 + u * neb * NT; if (i < NCP) { const int which = i / (BS * PER_B), r = i % (BS * PER_B), b = r / PER_B, o = r % PER_B;
            v[u] = __builtin_nontemporal_load((const f32x4*)((which ? c.cache_v : c.cache_k) + (size_t)b * 2048 * 256 + 4 * 256) + o); } }
#pragma unroll
        for (int u = 0; u < 8; ++u) { const int i = i0 + u * neb * NT; if (i < NCP) { const int which = i / (BS * PER_B), r = i % (BS * PER_B), b = r / PER_B, o = r % PER_B;
            __builtin_nontemporal_store(v[u], (f32x4*)(c.out + (which ? O_VS : O_KS) + (size_t)b * 2048 * 256) + o); } }
    }
}

template <bool SAMPLE>
__device__ __forceinline__ void ssd_item(const Ctx& c, int b, int h, unsigned char* lds) {
    const int tid = threadIdx.x, p = tid >> 3, nq = tid & 7, g = h >> 3;
    constexpr int CH = 32;
    float* xs = (float*)lds;
    float* Bs = xs + CH * 64;
    float* Cs = Bs + CH * 128;
    float* zs = Cs + CH * 128;
    float* ys = zs + CH * 64;
    float* dts = ys + CH * 64;
    float* das = dts + CH;
    const int T = SAMPLE ? TS : TP;
    float hs[16];
    if (SAMPLE) {
        const f32x4* s = (const f32x4*)(c.state_ssm + ((size_t)(b * 16 + h) * 64 + p) * 128 + 16 * nq);
#pragma unroll
        for (int j = 0; j < 4; ++j) { const f32x4 v = s[j]; hs[4 * j] = v.x; hs[4 * j + 1] = v.y; hs[4 * j + 2] = v.z; hs[4 * j + 3] = v.w; }
    } else {
#pragma unroll
        for (int j = 0; j < 16; ++j) hs[j] = 0.f;
    }
    const float A = -__expf(c.a_log[h]), Dh = c.d_skip[h], dtb = c.dt_bias[h];
    for (int t0 = 0; t0 < T; t0 += CH) {
        const int nt = (T - t0) < CH ? (T - t0) : CH;
        __syncthreads();
        for (int idx = tid; idx < nt * 384; idx += NT) {
            const int tt = idx / 384, cc = idx % 384;
            if (cc < 320) {
                const int col = cc < 64 ? h * 64 + cc : cc < 192 ? 1024 + g * 128 + (cc - 64) : 1280 + g * 128 + (cc - 192);
                float a = c.conv_b[col];
#pragma unroll
                for (int k = 0; k < 4; ++k) {
                    const int ts = t0 + tt - 3 + k; float xv;
                    if (SAMPLE) xv = ts >= 0 ? c.sproj[(size_t)(b * TS + ts) * NCOL + C_XBC + col] : c.state_conv[(size_t)(b * 3 + (ts + 3)) * CONVD + col];
                    else xv = ts >= 0 ? bf2f(c.proj[(size_t)(b * TP + ts) * NBIG + C_XBC + col]) : 0.f;
                    a += c.conv_w[k * CONVD + col] * xv;
                }
                const float v = silu_f(a);
                if (cc < 64) xs[tt * 64 + cc] = v; else if (cc < 192) Bs[tt * 128 + cc - 64] = v; else Cs[tt * 128 + cc - 192] = v;
            } else {
                const int pc = cc - 320;
                const float z = SAMPLE ? c.sproj[(size_t)(b * TS + t0 + tt) * NCOL + C_Z + h * 64 + pc] : bf2f(c.proj[(size_t)(b * TP + t0 + tt) * NBIG + C_Z + h * 64 + pc]);
                zs[tt * 64 + pc] = silu_f(z);
            }
        }
        if (tid < nt) {
            const float dt = SAMPLE ? softplus_f(c.sproj[(size_t)(b * TS + t0 + tid) * NCOL + C_DT + h] + dtb) : c.dt[(size_t)(b * TP + t0 + tid) * 16 + h];
            dts[tid] = dt; das[tid] = __expf(dt * A);
        }
        __syncthreads();
        for (int tt = 0; tt < nt; ++tt) {
            const float dt = dts[tt], dA = das[tt], xv = xs[tt * 64 + p], dx = dt * xv;
            const f32x4* bp = (const f32x4*)(Bs + tt * 128 + 16 * nq); const f32x4* cp = (const f32x4*)(Cs + tt * 128 + 16 * nq);
            float y = 0.f;
#pragma unroll
            for (int j = 0; j < 4; ++j) {
                const f32x4 bv = bp[j], cv = cp[j];
                hs[4 * j] = hs[4 * j] * dA + dx * bv.x; y += hs[4 * j] * cv.x;
                hs[4 * j + 1] = hs[4 * j + 1] * dA + dx * bv.y; y += hs[4 * j + 1] * cv.y;
                hs[4 * j + 2] = hs[4 * j + 2] * dA + dx * bv.z; y += hs[4 * j + 2] * cv.z;
                hs[4 * j + 3] = hs[4 * j + 3] * dA + dx * bv.w; y += hs[4 * j + 3] * cv.w;
            }
            y += __shfl_xor(y, 1); y += __shfl_xor(y, 2); y += __shfl_xor(y, 4);
            if (nq == 0) ys[tt * 64 + p] = (y + Dh * xv) * zs[tt * 64 + p];
        }
        __syncthreads();
        {
            const int tt = tid >> 4, pq = tid & 15;
            f32x4 v = {0.f, 0.f, 0.f, 0.f};
            if (tt < nt) v = *(const f32x4*)(ys + tt * 64 + 4 * pq);
            float ss = (v.x * v.x + v.y * v.y) + (v.z * v.z + v.w * v.w);
            ss += __shfl_xor(ss, 1); ss += __shfl_xor(ss, 2); ss += __shfl_xor(ss, 4); ss += __shfl_xor(ss, 8);
            if (tt < nt) {
                const size_t row = SAMPLE ? (size_t)(MP + b * TS + t0 + tt) : (size_t)(b * TP + t0 + tt);
                *(unsigned long long*)(c.ymix + row * DM + h * 64 + 4 * pq) = (unsigned long long)pk2(v.x, v.y) | ((unsigned long long)pk2(v.z, v.w) << 32);
                if (pq == 0) c.ssq[row * 16 + h] = ss;
            }
        }
    }
    {
        f32x4* d = (f32x4*)(c.out + (SAMPLE ? O_HS : O_HP) + ((size_t)(b * 16 + h) * 64 + p) * 128 + 16 * nq);
#pragma unroll
        for (int j = 0; j < 4; ++j) d[j] = (f32x4){hs[4 * j], hs[4 * j + 1], hs[4 * j + 2], hs[4 * j + 3]};
    }
    if (SAMPLE) {
        for (int i = tid; i < 3 * 96; i += NT) { const int j = i / 96, cc = h * 96 + i % 96; c.out[O_CS + (size_t)(b * 3 + j) * CONVD + cc] = c.sproj[(size_t)(b * TS + 1 + j) * NCOL + C_XBC + cc]; }
    }
    __syncthreads();
}

typedef unsigned u32x2v __attribute__((ext_vector_type(2)));

constexpr int PB = 136, PX = 72;
typedef short v4i16_t __attribute__((ext_vector_type(4)));
__device__ __forceinline__ u32x2v tr_read(const bf16_t* p) { return __builtin_bit_cast(u32x2v, __builtin_amdgcn_ds_read_tr16_b64_v4i16((LAS v4i16_t*)p)); }
__device__ __forceinline__ bf16x8 tr_pair(const bf16_t* p0, const bf16_t* p1) { const u32x2v a = tr_read(p0), b = tr_read(p1); const u32x4 w = {a.x, a.y, b.x, b.y}; return __builtin_bit_cast(bf16x8, w); }
__device__ __forceinline__ u32x4 pack8(const float (&v)[8]) { u32x4 w; w.x = pk2(v[0], v[1]); w.y = pk2(v[2], v[3]); w.z = pk2(v[4], v[5]); w.w = pk2(v[6], v[7]); return w; }
constexpr int PXQ = 264;
__device__ __forceinline__ void ssd_a_item(const Ctx& c, int item, unsigned char* lds) {
    const int tid = threadIdx.x, lane = tid & 63, wave = __builtin_amdgcn_readfirstlane(tid >> 6); int fr = lane & 15, fq = lane >> 4;
    const int hh = item & 1, g = (item >> 1) & 1, ch = (item >> 2) & 15, b = item >> 6, h0 = 8 * g + 4 * hh;
    bf16_t* Bs = (bf16_t*)lds; bf16_t* Cs = Bs + 128 * PB; bf16_t* Xs = Cs + 128 * PB;
    float* cumA = (float*)(Xs + 128 * PXQ); float* dtsA = cumA + 512; float* wA = dtsA + 512;
    const size_t rowb = (size_t)b * TP + ch * 128;
    __syncthreads();
    if (wave < 4) {
        const int h = h0 + wave; const float A = -__expf(c.a_log[h]);
        const float d0 = c.dt[(rowb + 2 * lane) * 16 + h], d1 = c.dt[(rowb + 2 * lane + 1) * 16 + h];
        const float x0 = A * d0, x1 = A * d1; float incl = x0 + x1;
#pragma unroll
        for (int off = 1; off < 64; off <<= 1) { const float t = __shfl_up(incl, off); if (lane >= off) incl += t; }
        const float c1 = incl, c0 = incl - x1, cl = __shfl(c1, 63);
        cumA[wave * 128 + 2 * lane] = c0; cumA[wave * 128 + 2 * lane + 1] = c1; dtsA[wave * 128 + 2 * lane] = d0; dtsA[wave * 128 + 2 * lane + 1] = d1;
        wA[wave * 128 + 2 * lane] = __expf(cl - c0) * d0; wA[wave * 128 + 2 * lane + 1] = __expf(cl - c1) * d1;
        c.el[(rowb + 2 * lane) * 16 + h] = __expf(c0); c.el[(rowb + 2 * lane + 1) * 16 + h] = __expf(c1);
        if (lane == 63) c.cd[(b * 16 + ch) * 16 + h] = __expf(c1);
    }
    {
        const int o = lane;
        const int xcol = o < 32 ? h0 * 64 + 8 * o : o < 48 ? 1024 + g * 128 + 8 * (o - 32) : 1280 + g * 128 + 8 * (o - 48);
        float cwr[5][8];
#pragma unroll
        for (int k = 0; k < 5; ++k) { const float* wp = (k < 4 ? c.conv_w + k * CONVD : c.conv_b) + xcol; const f32x4 a = *(const f32x4*)wp, b2 = *(const f32x4*)(wp + 4);
            cwr[k][0] = a.x; cwr[k][1] = a.y; cwr[k][2] = a.z; cwr[k][3] = a.w; cwr[k][4] = b2.x; cwr[k][5] = b2.y; cwr[k][6] = b2.z; cwr[k][7] = b2.w; }
        const bf16_t* src = c.proj + (size_t)(b * TP) * NBIG + C_XBC + xcol;
#pragma unroll 1
        for (int hf = 0; hf < 2; ++hf) {
            const int s0 = 16 * wave + 8 * hf;
            u32x4 raw[11];
#pragma unroll
            for (int j = 0; j < 11; ++j) { const int t = ch * 128 + s0 - 3 + j; raw[j] = (u32x4){0u, 0u, 0u, 0u}; if (t >= 0) raw[j] = *(const u32x4*)(src + (size_t)t * NBIG); }
#pragma unroll
            for (int i = 0; i < 8; ++i) {
                float v[8];
#pragma unroll
                for (int e = 0; e < 8; ++e) v[e] = cwr[4][e];
#pragma unroll
                for (int k = 0; k < 4; ++k) { const u32x4 u = raw[i + k];
                    v[0] += cwr[k][0] * bf_lo(u.x); v[1] += cwr[k][1] * bf_hi(u.x); v[2] += cwr[k][2] * bf_lo(u.y); v[3] += cwr[k][3] * bf_hi(u.y);
                    v[4] += cwr[k][4] * bf_lo(u.z); v[5] += cwr[k][5] * bf_hi(u.z); v[6] += cwr[k][6] * bf_lo(u.w); v[7] += cwr[k][7] * bf_hi(u.w); }
#pragma unroll
                for (int e = 0; e < 8; ++e) v[e] = silu_f(v[e]);
                const u32x4 pw = pack8(v); const int sidx = s0 + i;
                if (o < 32) *(u32x4*)(Xs + sidx * PXQ + 8 * o) = pw;
                else if (o < 48) *(u32x4*)(Bs + sidx * PB + 8 * (o - 32)) = pw;
                else { *(u32x4*)(Cs + sidx * PB + 8 * (o - 48)) = pw; if (hh == 0) *(u32x4*)(c.xcc + (rowb + sidx) * 256 + g * 128 + 8 * (o - 48)) = pw; }
            }
        }
    }
    __syncthreads();
    asm volatile("" : "+v"(fr), "+v"(fq));
    const int l = 16 * wave + fr;
    f32x4 ga[4], gb[4];
    {
        bf16x8 cf[4];
#pragma unroll
        for (int kk = 0; kk < 4; ++kk) cf[kk] = *(const bf16x8*)(Cs + l * PB + 8 * fq + 32 * kk);
#pragma unroll
        for (int ks = 0; ks < 4; ++ks) {
            ga[ks] = (f32x4){0.f, 0.f, 0.f, 0.f}; gb[ks] = (f32x4){0.f, 0.f, 0.f, 0.f};
            if (ks <= (wave >> 1)) {
#pragma unroll
                for (int kk = 0; kk < 4; ++kk) ga[ks] = __builtin_amdgcn_mfma_f32_16x16x32_bf16(*(const bf16x8*)(Bs + (32 * ks + fr) * PB + 8 * fq + 32 * kk), cf[kk], ga[ks], 0, 0, 0);
                if (2 * ks + 1 <= wave) {
#pragma unroll
                    for (int kk = 0; kk < 4; ++kk) gb[ks] = __builtin_amdgcn_mfma_f32_16x16x32_bf16(*(const bf16x8*)(Bs + (32 * ks + 16 + fr) * PB + 8 * fq + 32 * kk), cf[kk], gb[ks], 0, 0, 0);
                }
            }
        }
    }
    const int spt = wave & 3, snh = wave >> 2;
#pragma unroll 1
    for (int j = 0; j < 4; ++j) {
        const int h = h0 + j; const float Dh = c.d_skip[h];
        const float* cumj = cumA + j * 128; const float* dtj = dtsA + j * 128; const float* wj = wA + j * 128;
        const float cl_l = cumj[l];
        f32x4 acc[4];
#pragma unroll
        for (int pt = 0; pt < 4; ++pt) acc[pt] = (f32x4){0.f, 0.f, 0.f, 0.f};
#pragma unroll
        for (int ks = 0; ks < 4; ++ks) {
            if (ks <= (wave >> 1)) {
                const f32x4 ca = *(const f32x4*)(cumj + 32 * ks + 4 * fq), cb = *(const f32x4*)(cumj + 32 * ks + 16 + 4 * fq);
                const f32x4 da = *(const f32x4*)(dtj + 32 * ks + 4 * fq), db = *(const f32x4*)(dtj + 32 * ks + 16 + 4 * fq);
                float m[8];
#pragma unroll
                for (int e = 0; e < 4; ++e) {
                    const int sA = 32 * ks + 4 * fq + e;
                    m[e] = (sA <= l) ? ga[ks][e] * __expf(cl_l - ca[e]) * da[e] : 0.f;
                    m[4 + e] = (sA + 16 <= l) ? gb[ks][e] * __expf(cl_l - cb[e]) * db[e] : 0.f;
                }
                const bf16x8 mb = __builtin_bit_cast(bf16x8, pack8(m));
#pragma unroll
                for (int pt = 0; pt < 4; ++pt) {
                    const bf16_t* xp = Xs + (32 * ks + 4 * fq + (fr >> 2)) * PXQ + 64 * j + 16 * pt + 4 * (fr & 3);
                    acc[pt] = __builtin_amdgcn_mfma_f32_16x16x32_bf16(tr_pair(xp, xp + 16 * PXQ), mb, acc[pt], 0, 0, 0);
                }
            }
        }
#pragma unroll
        for (int pt = 0; pt < 4; ++pt) {
            const int p0 = 16 * pt + 4 * fq;
            const u32x2v xv = *(const u32x2v*)(Xs + l * PXQ + 64 * j + p0);
            const f32x4 y = {acc[pt][0] + Dh * bf_lo(xv.x), acc[pt][1] + Dh * bf_hi(xv.x), acc[pt][2] + Dh * bf_lo(xv.y), acc[pt][3] + Dh * bf_hi(xv.y)};
            *(f32x4*)(c.yd + (rowb + l) * 1024 + h * 64 + p0) = y;
        }
        f32x4 sacc[4];
#pragma unroll
        for (int nt = 0; nt < 4; ++nt) sacc[nt] = (f32x4){0.f, 0.f, 0.f, 0.f};
#pragma unroll
        for (int ks = 0; ks < 4; ++ks) {
            const bf16_t* xp = Xs + (32 * ks + 8 * fq + (fr >> 2)) * PXQ + 64 * j + 16 * spt + 4 * (fr & 3);
            const u32x2v xa = tr_read(xp), xb = tr_read(xp + 4 * PXQ);
            const f32x4 wa = *(const f32x4*)(wj + 32 * ks + 8 * fq), wb = *(const f32x4*)(wj + 32 * ks + 8 * fq + 4);
            u32x4 xw; xw.x = pk2(bf_lo(xa.x) * wa.x, bf_hi(xa.x) * wa.y); xw.y = pk2(bf_lo(xa.y) * wa.z, bf_hi(xa.y) * wa.w);
            xw.z = pk2(bf_lo(xb.x) * wb.x, bf_hi(xb.x) * wb.y); xw.w = pk2(bf_lo(xb.y) * wb.z, bf_hi(xb.y) * wb.w);
            const bf16x8 xf = __builtin_bit_cast(bf16x8, xw);
#pragma unroll
            for (int nt = 0; nt < 4; ++nt) { const bf16_t* bp = Bs + (32 * ks + 8 * fq + (fr >> 2)) * PB + 16 * (4 * snh + nt) + 4 * (fr & 3);
                sacc[nt] = __builtin_amdgcn_mfma_f32_16x16x32_bf16(xf, tr_pair(bp, bp + 4 * PB), sacc[nt], 0, 0, 0); }
        }
        float* sp = c.st + ((size_t)((b * 16 + ch) * 16 + h)) * 8192 + (size_t)(16 * spt + 4 * fq) * 128 + 16 * (4 * snh) + fr;
#pragma unroll
        for (int nt = 0; nt < 4; ++nt)
#pragma unroll
            for (int e = 0; e < 4; ++e) sp[e * 128 + 16 * nt] = sacc[nt][e];
    }
}
__device__ __forceinline__ void ssd_chain_item(const Ctx& c, int b, int h, unsigned char* lds) {
    const int tid = threadIdx.x, lane = tid & 63, wave = __builtin_amdgcn_readfirstlane(tid >> 6), g = h >> 3; int fr = lane & 15, fq = lane >> 4;
    bf16_t* hB = (bf16_t*)lds;
    const int hp = tid >> 3, hn = 16 * (tid & 7);
    float hs[16];
#pragma unroll
    for (int i = 0; i < 16; ++i) hs[i] = 0.f;
    __syncthreads();
    { const u32x4 z4 = {0u, 0u, 0u, 0u}; *(u32x4*)(hB + hp * PB + hn) = z4; *(u32x4*)(hB + hp * PB + hn + 8) = z4; }
    const float* stp = c.st + ((size_t)(b * 16) * 16 + h) * 8192 + (size_t)hp * 128 + hn;
    f32x4 stn[2][4]; bf16x8 cfn[2][4]; f32x4 ydn[2][4]; u32x2v zn[2][4]; float eln[2], cdn[2];
#define CHAIN_LOAD(chx, S) do { const size_t r_ = (size_t)b * TP + (chx) * 128 + 16 * wave + fr; \
        _Pragma("unroll") for (int i = 0; i < 4; ++i) stn[S][i] = *(const f32x4*)(stp + (size_t)(chx) * 16 * 8192 + 4 * i); \
        _Pragma("unroll") for (int kk = 0; kk < 4; ++kk) cfn[S][kk] = *(const bf16x8*)(c.xcc + r_ * 256 + g * 128 + 8 * fq + 32 * kk); \
        _Pragma("unroll") for (int pt = 0; pt < 4; ++pt) { ydn[S][pt] = *(const f32x4*)(c.yd + r_ * 1024 + h * 64 + 16 * pt + 4 * fq); zn[S][pt] = *(const u32x2v*)(c.proj + r_ * NBIG + C_Z + h * 64 + 16 * pt + 4 * fq); } \
        eln[S] = c.el[r_ * 16 + h]; cdn[S] = c.cd[(b * 16 + (chx)) * 16 + h]; } while (0)
    CHAIN_LOAD(0, 0); CHAIN_LOAD(1, 1);
    __syncthreads();
#pragma unroll 1
    for (int ch2 = 0; ch2 < 16; ch2 += 2) {
        asm volatile("" : "+v"(fr), "+v"(fq));
#pragma unroll
        for (int j = 0; j < 2; ++j) {
        const int ch = ch2 + j;
        const size_t orow = (size_t)b * TP + ch * 128 + 16 * wave + fr;
        bf16x8 cf[4]; f32x4 ydr[4]; u32x2v zr[4]; f32x4 stc[4];
#pragma unroll
        for (int i = 0; i < 4; ++i) { cf[i] = cfn[j][i]; ydr[i] = ydn[j][i]; zr[i] = zn[j][i]; stc[i] = stn[j][i]; }
        const float el = eln[j], cdv = cdn[j];
        if (ch + 2 < 16) CHAIN_LOAD(ch + 2, j);
        float ss = 0.f;
#pragma unroll
        for (int pt = 0; pt < 4; ++pt) {
            f32x4 acc = {0.f, 0.f, 0.f, 0.f};
#pragma unroll
            for (int kk = 0; kk < 4; ++kk) acc = __builtin_amdgcn_mfma_f32_16x16x32_bf16(*(const bf16x8*)(hB + (16 * pt + fr) * PB + 8 * fq + 32 * kk), cf[kk], acc, 0, 0, 0);
            const float y0 = (ydr[pt][0] + el * acc[0]) * bf_lo(zr[pt].x), y1 = (ydr[pt][1] + el * acc[1]) * bf_hi(zr[pt].x);
            const float y2 = (ydr[pt][2] + el * acc[2]) * bf_lo(zr[pt].y), y3 = (ydr[pt][3] + el * acc[3]) * bf_hi(zr[pt].y);
            ss += (y0 * y0 + y1 * y1) + (y2 * y2 + y3 * y3);
            u32x2v w; w.x = pk2(y0, y1); w.y = pk2(y2, y3);
            *(u32x2v*)(c.ymix + orow * DM + h * 64 + 16 * pt + 4 * fq) = w;
        }
        ss += __shfl_xor(ss, 16); ss += __shfl_xor(ss, 32);
        if (fq == 0) c.ssq[orow * 16 + h] = ss;
#pragma unroll
        for (int i = 0; i < 4; ++i) { hs[4 * i] = hs[4 * i] * cdv + stc[i].x; hs[4 * i + 1] = hs[4 * i + 1] * cdv + stc[i].y; hs[4 * i + 2] = hs[4 * i + 2] * cdv + stc[i].z; hs[4 * i + 3] = hs[4 * i + 3] * cdv + stc[i].w; }
        __syncthreads();
        { u32x4 w0, w1; w0.x = pk2(hs[0], hs[1]); w0.y = pk2(hs[2], hs[3]); w0.z = pk2(hs[4], hs[5]); w0.w = pk2(hs[6], hs[7]);
          w1.x = pk2(hs[8], hs[9]); w1.y = pk2(hs[10], hs[11]); w1.z = pk2(hs[12], hs[13]); w1.w = pk2(hs[14], hs[15]);
          *(u32x4*)(hB + hp * PB + hn) = w0; *(u32x4*)(hB + hp * PB + hn + 8) = w1; }
        __syncthreads();
        }
    }
#undef CHAIN_LOAD
    {
        f32x4* d = (f32x4*)(c.out + O_HP + ((size_t)(b * 16 + h) * 64 + hp) * 128 + hn);
#pragma unroll
        for (int i = 0; i < 4; ++i) d[i] = (f32x4){hs[4 * i], hs[4 * i + 1], hs[4 * i + 2], hs[4 * i + 3]};
    }
    __syncthreads();
}

__device__ __forceinline__ int att_off(int e, bool& in_range) {
    in_range = e < 387;
    const int br = e < 129 ? 0 : e < 258 ? 1 : 2; const int j = e - 129 * br;
    return br == 0 ? j : br == 1 ? 4 * j : 16 * j;
}
__device__ __forceinline__ void attn_branch2(const bf16_t* Kb  , const bf16_t* Vt  , const bf16x8* qs, f32x4 (&o)[4][4], float (&l)[4],
                                             int t0, int r, int fr, int fq, float bnd, bf16_t* vls, int lane) {
    const int qp = fr >> 2, ur = (t0 >> 4) + qp;
    const int nsteps = (((t0 >> 4) + 4) + 31) >> 5;
#pragma unroll
    for (int cp = 0; cp < 2; ++cp) {
#pragma unroll 1
        for (int st = 0; st < nsteps; ++st) {
            const int ustep = 32 * st;
            bf16x8 kA[2][2], kB[2][2];
#pragma unroll
            for (int x = 0; x < 2; ++x) {
                const int cc = 2 * cp + x;
                const int sA = 16 * (ustep + fr) + 4 * cc + r, sB = sA + 256;
                const bf16_t* pa = Kb + (size_t)sA * NBIG; const bf16_t* pb = Kb + (size_t)(sB > 2047 ? 2047 : sB) * NBIG;
                kA[x][0] = *(const bf16x8*)pa; kA[x][1] = *(const bf16x8*)(pa + 32); kB[x][0] = *(const bf16x8*)pb; kB[x][1] = *(const bf16x8*)(pb + 32);
            }
            u32x4 vraw[2][4];
#pragma unroll
            for (int x = 0; x < 2; ++x) {
                const int cc = 2 * cp + x;
#pragma unroll
                for (int i = 0; i < 4; ++i) { int pos = 16 * (ustep + (lane >> 3) + 8 * i) + 4 * cc + r; pos = pos > TP - 1 ? TP - 1 : pos; vraw[x][i] = *(const u32x4*)(Vt + (size_t)pos * NBIG + 8 * (lane & 7)); }
            }
#pragma unroll
            for (int x = 0; x < 2; ++x) {
                const int c = 2 * cp + x;
                const bf16x8 q0 = qs[(2 * c) * 64], q1 = qs[(2 * c + 1) * 64];
                f32x4 sa = {0.f, 0.f, 0.f, 0.f}, sb = {0.f, 0.f, 0.f, 0.f};
                sa = __builtin_amdgcn_mfma_f32_16x16x32_bf16(kA[x][0], q0, sa, 0, 0, 0); sa = __builtin_amdgcn_mfma_f32_16x16x32_bf16(kA[x][1], q1, sa, 0, 0, 0);
                sb = __builtin_amdgcn_mfma_f32_16x16x32_bf16(kB[x][0], q0, sb, 0, 0, 0); sb = __builtin_amdgcn_mfma_f32_16x16x32_bf16(kB[x][1], q1, sb, 0, 0, 0);
                const int dA = ur - (ustep + 4 * fq);
                float p[8]; float ls = 0.f;
#pragma unroll
                for (int e = 0; e < 4; ++e) {
                    const int d0 = dA - e, d1 = dA - 16 - e;
                    p[e] = d0 >= 0 ? __builtin_amdgcn_exp2f(sa[e] - bnd) : 0.f; p[4 + e] = d1 >= 0 ? __builtin_amdgcn_exp2f(sb[e] - bnd) : 0.f;
                    ls += p[e] + p[4 + e];
                }
                l[c] += ls;
                const u32x4 pw = {pk2(p[0], p[1]), pk2(p[2], p[3]), pk2(p[4], p[5]), pk2(p[6], p[7])};
                const bf16x8 pbf = __builtin_bit_cast(bf16x8, pw);
                bf16x8 vf[4];
                {
                    bf16_t* vl = vls + x * 2048;
                    asm volatile("" ::: "memory");
#pragma unroll
                    for (int i = 0; i < 4; ++i) *(u32x4*)(vl + ((lane >> 3) + 8 * i) * 64 + 8 * (lane & 7)) = vraw[x][i];
                    asm volatile("" ::: "memory");
#pragma unroll
                    for (int dt = 0; dt < 4; ++dt) { const bf16_t* vp = vl + (4 * fq + (fr >> 2)) * 64 + 16 * dt + 4 * (fr & 3); vf[dt] = tr_pair(vp, vp + 16 * 64); }
                    asm volatile("" ::: "memory");
                }
#pragma unroll
                for (int dt = 0; dt < 4; ++dt) o[c][dt] = __builtin_amdgcn_mfma_f32_16x16x32_bf16(vf[dt], pbf, o[c][dt], 0, 0, 0);
            }
        }
    }
}
template <int BR>
__device__ __forceinline__ void attn_branch(const bf16_t* Kb  , const bf16_t* Vt  , const bf16x8* qs  , f32x4 (&o)[4][4], float (&l)[4],
                                            int t0, int r, int fr, int fq, float bnd, bf16_t* vls  , int lane) {
    constexpr int DIL = BR == 0 ? 1 : BR == 1 ? 4 : 16, LEN = 2048 / DIL;
    const int qp = fr >> 2;
    const int ukbase = BR == 0 ? t0 - 128 : BR == 1 ? (t0 >> 2) - 128 : 0;
    const int nsteps = BR == 0 ? 6 : BR == 1 ? 5 : (((t0 >> 4) + 4) + 31) >> 5;
    const int first = ukbase < 0 ? ((-ukbase) >> 5) : 0;
#pragma unroll
    for (int cc = 0; cc < (BR == 2 ? 4 : 1); ++cc) {
        bf16x8 kAn[2], kBn[2];
#define ATT_LOADK(stp) do { const int us_ = ukbase + 32 * (stp); \
            int uA = us_ + fr, uB = uA + 16; uA = uA < 0 ? 0 : uA; uB = uB < 0 ? 0 : uB; \
            const int sA = BR == 0 ? uA : BR == 1 ? 4 * uA + r : 16 * uA + 4 * cc + r, sB = BR == 0 ? uB : BR == 1 ? 4 * uB + r : 16 * uB + 4 * cc + r; \
            const bf16_t* pa = Kb + (size_t)sA * NBIG; const bf16_t* pb = Kb + (size_t)sB * NBIG; \
            kAn[0] = *(const bf16x8*)pa; kAn[1] = *(const bf16x8*)(pa + 32); kBn[0] = *(const bf16x8*)pb; kBn[1] = *(const bf16x8*)(pb + 32); } while (0)
        if (first < nsteps) ATT_LOADK(first);
#pragma unroll 1
        for (int st = first; st < nsteps; ++st) {
            const int ustep = ukbase + 32 * st;
            bf16x8 kA[2], kB[2], vf[4];
            kA[0] = kAn[0]; kA[1] = kAn[1]; kB[0] = kBn[0]; kB[1] = kBn[1];
            u32x4 vraw[4];
#pragma unroll
            for (int i = 0; i < 4; ++i) {
                int u = ustep + (lane >> 3) + 8 * i; u = u < 0 ? 0 : u;
                int pos = BR == 0 ? u : 4 * u + r; pos = pos > TP - 1 ? TP - 1 : pos;
                vraw[i] = *(const u32x4*)(Vt + (size_t)pos * NBIG + 8 * (lane & 7));
            }
            if (st + 1 < nsteps) ATT_LOADK(st + 1);
#pragma unroll
            for (int c4 = 0; c4 < (BR == 2 ? 1 : 4); ++c4) {
                const int c = BR == 2 ? cc : c4;
                f32x4 sa = {0.f, 0.f, 0.f, 0.f}, sb = {0.f, 0.f, 0.f, 0.f};
                const bf16x8 q0 = qs[(2 * c) * 64], q1 = qs[(2 * c + 1) * 64];
                sa = __builtin_amdgcn_mfma_f32_16x16x32_bf16(kA[0], q0, sa, 0, 0, 0); sa = __builtin_amdgcn_mfma_f32_16x16x32_bf16(kA[1], q1, sa, 0, 0, 0);
                sb = __builtin_amdgcn_mfma_f32_16x16x32_bf16(kB[0], q0, sb, 0, 0, 0); sb = __builtin_amdgcn_mfma_f32_16x16x32_bf16(kB[1], q1, sb, 0, 0, 0);
                const int ur = BR == 0 ? t0 + 16 * qp + 4 * c + r : BR == 1 ? (t0 >> 2) + 4 * qp + c : (t0 >> 4) + qp;
                const int dA = ur - (ustep + 4 * fq);
                float p[8]; float ls = 0.f;
#pragma unroll
                for (int e = 0; e < 4; ++e) {
                    const int d0 = dA - e, d1 = dA - 16 - e;
                    const bool v0 = d0 >= 0 && d0 <= 128 && d0 <= ur, v1 = d1 >= 0 && d1 <= 128 && d1 <= ur;
                    p[e] = v0 ? __builtin_amdgcn_exp2f(sa[e] - bnd) : 0.f; p[4 + e] = v1 ? __builtin_amdgcn_exp2f(sb[e] - bnd) : 0.f;
                    ls += p[e] + p[4 + e];
                }
                l[c] += ls;
                const u32x4 pw = {pk2(p[0], p[1]), pk2(p[2], p[3]), pk2(p[4], p[5]), pk2(p[6], p[7])};
                const bf16x8 pb = __builtin_bit_cast(bf16x8, pw);
                if (c4 == 0) {
                    asm volatile("" ::: "memory");
#pragma unroll
                    for (int i = 0; i < 4; ++i) *(u32x4*)(vls + ((lane >> 3) + 8 * i) * 64 + 8 * (lane & 7)) = vraw[i];
                    asm volatile("" ::: "memory");
#pragma unroll
                    for (int dt = 0; dt < 4; ++dt) { const bf16_t* vp = vls + (4 * fq + (fr >> 2)) * 64 + 16 * dt + 4 * (fr & 3); vf[dt] = tr_pair(vp, vp + 16 * 64); }
                    asm volatile("" ::: "memory");
                }
#pragma unroll
                for (int dt = 0; dt < 4; ++dt) o[c][dt] = __builtin_amdgcn_mfma_f32_16x16x32_bf16(vf[dt], pb, o[c][dt], 0, 0, 0);
            }
        }
#undef ATT_LOADK
    }
}
__device__ __forceinline__ void attn_prompt_mfma(const Ctx& c, int item, int lane, float bnd, bf16x8* qs, bf16_t* vls) {
    const int fr = lane & 15, fq = lane >> 4, g = fr & 3, qp = fr >> 2;
    const int tile = 31 - (item >> 6), rest = item & 63, b = rest >> 4, kvh = (rest >> 2) & 3, r = rest & 3, t0 = tile * 64;
    const size_t row0 = (size_t)b * TP + t0 + 16 * qp + r;
    {
        const bf16_t* Qb = c.proj + row0 * NBIG + C_Q + (kvh * 4 + g) * 64 + 8 * fq;
#pragma unroll
        for (int cq = 0; cq < 4; ++cq) { qs[(2 * cq) * 64] = *(const bf16x8*)(Qb + (size_t)(4 * cq) * NBIG); qs[(2 * cq + 1) * 64] = *(const bf16x8*)(Qb + (size_t)(4 * cq) * NBIG + 32); }
    }
    f32x4 o[4][4]; float l[4];
#pragma unroll
    for (int cq = 0; cq < 4; ++cq) { l[cq] = 0.f;
#pragma unroll
        for (int dt = 0; dt < 4; ++dt) o[cq][dt] = (f32x4){0.f, 0.f, 0.f, 0.f}; }
    const bf16_t* Kb = c.proj + (size_t)b * TP * NBIG + C_K + kvh * 64 + 8 * fq;
    const int bk = b * 4 + kvh;
    const bf16_t* Vb = c.proj + (size_t)b * TP * NBIG + C_V + kvh * 64;
    attn_branch<0>(Kb, Vb, qs, o, l, t0, r, fr, fq, bnd, vls, lane);
    attn_branch<1>(Kb, Vb, qs, o, l, t0, r, fr, fq, bnd, vls, lane);
    attn_branch2(Kb, Vb, qs, o, l, t0, r, fr, fq, bnd, vls, lane);
#pragma unroll
    for (int cq = 0; cq < 4; ++cq) {
        float ls = l[cq]; ls += __shfl_xor(ls, 16); ls += __shfl_xor(ls, 32);
        const float inv = 1.f / ls;
        const size_t row = row0 + 4 * cq;
        const bf16_t* gp = c.proj + row * NBIG + C_G + (kvh * 4 + g) * 64 + 4 * fq;
        bf16_t* yp = c.ymix + row * DM + 1024 + (kvh * 4 + g) * 64 + 4 * fq;
#pragma unroll
        for (int dt = 0; dt < 4; ++dt) {
            const u32x2v gw = *(const u32x2v*)(gp + 16 * dt);
            u32x2v w; w.x = pk2(o[cq][dt][0] * inv * bf_lo(gw.x), o[cq][dt][1] * inv * bf_hi(gw.x)); w.y = pk2(o[cq][dt][2] * inv * bf_lo(gw.y), o[cq][dt][3] * inv * bf_hi(gw.y));
            *(u32x2v*)(yp + 16 * dt) = w;
        }
    }
}
__device__ __forceinline__ float norm_rope_lane(float raw, const float* nw, const float* rope, int pidx, int lane) {
    const float ss = wave_sum(raw * raw);
    const float v = raw * rsqrtf(ss * (1.f / 64.f) + EPS) * nw[lane];
    const float partner = __shfl_xor(v, 8);
    const float cs = rope[(size_t)pidx * 16 + 2 * (lane & 7)], sn = rope[(size_t)pidx * 16 + 2 * (lane & 7) + 1];
    return lane < 8 ? v * cs - partner * sn : lane < 16 ? v * cs + partner * sn : v;
}
__device__ __forceinline__ void attn_sample_wave(const Ctx& c, int item, int lane, float* sl  , float* wl  ) {
    const int br = item % 3, rest = item / 3, kvh = rest & 3, i = (rest >> 2) & 3, b = rest >> 4;
    const int dil = br == 0 ? 1 : br == 1 ? 4 : 16;
    float vnew[4];
#pragma unroll
    for (int j = 0; j < 4; ++j) {
        const float* sp = c.sproj + (size_t)(b * TS + j) * NCOL;
        const float kn = norm_rope_lane(sp[C_K + kvh * 64 + lane], c.k_norm_w, c.rope, TP + j, lane);
        vnew[j] = sp[C_V + kvh * 64 + lane];
        wl[j * 64 + lane] = kn;
        if (i == 3 && br == 0) {
            c.out[O_KS + ((size_t)(b * 2048 + 2044 + j) * 4 + kvh) * 64 + lane] = kn;
            c.out[O_VS + ((size_t)(b * 2048 + 2044 + j) * 4 + kvh) * 64 + lane] = vnew[j];
        }
    }
    const float* CK = c.cache_k + (size_t)b * 2048 * 256 + kvh * 64;
    const float* CV = c.cache_v + (size_t)b * 2048 * 256 + kvh * 64;
    const float* spi = c.sproj + (size_t)(b * TS + i) * NCOL;
    float* ql = wl + 256;
#pragma unroll
    for (int gq = 0; gq < 4; ++gq) ql[gq * 64 + lane] = norm_rope_lane(spi[C_Q + (kvh * 4 + gq) * 64 + lane], c.q_norm_w, c.rope, TP + i, lane) * 0.125f;
    asm volatile("s_waitcnt lgkmcnt(0)" ::: "memory");
#pragma unroll 1
    for (int r = 0; r < 3; ++r) {
        const int e = lane + 64 * r; const int idx = 2048 + i - e * dil;
        const bool ok = e <= 128;
        const float* kp = (idx >= 2048 || !ok) ? wl + (ok ? idx - 2048 : 0) * 64 : CK + (size_t)idx * 256;
        f32x4 kr[16];
#pragma unroll
        for (int q4 = 0; q4 < 16; ++q4) kr[q4] = *(const f32x4*)(kp + 4 * q4);
#pragma unroll 1
        for (int gq = 0; gq < 4; ++gq) {
            float a = 0.f;
#pragma unroll
            for (int q4 = 0; q4 < 16; ++q4) { const f32x4 qv = *(const f32x4*)(ql + gq * 64 + 4 * q4); a += qv.x * kr[q4].x + qv.y * kr[q4].y + qv.z * kr[q4].z + qv.w * kr[q4].w; }
            sl[gq * 192 + e] = ok ? a : -INFINITY;
        }
    }
    asm volatile("s_waitcnt lgkmcnt(0)" ::: "memory");
    float mx[4];
#pragma unroll
    for (int gq = 0; gq < 4; ++gq) mx[gq] = fmaxf(fmaxf(sl[gq * 192 + lane], sl[gq * 192 + 64 + lane]), sl[gq * 192 + 128 + lane]);
    float lsum[4];
#pragma unroll
    for (int gq = 0; gq < 4; ++gq) { mx[gq] = wave_max(mx[gq]); lsum[gq] = 0.f; }
#pragma unroll 1
    for (int r = 0; r < 3; ++r) {
        const int e = lane + 64 * r;
#pragma unroll
        for (int gq = 0; gq < 4; ++gq) { const float sv = sl[gq * 192 + e]; const float pv = (sv == -INFINITY) ? 0.f : __expf(sv - mx[gq]); lsum[gq] += pv; sl[gq * 192 + e] = pv; }
    }
#pragma unroll
    for (int gq = 0; gq < 4; ++gq) lsum[gq] = wave_sum(lsum[gq]);
    asm volatile("s_waitcnt lgkmcnt(0)" ::: "memory");
    float o[4] = {0.f, 0.f, 0.f, 0.f};
    const int nnew = br == 0 ? i + 1 : 1;
#pragma unroll
    for (int e = 0; e < 4; ++e) {
        if (e < nnew) { const int j = i - e * dil; const float vv = j == 0 ? vnew[0] : j == 1 ? vnew[1] : j == 2 ? vnew[2] : vnew[3];
#pragma unroll
            for (int gq = 0; gq < 4; ++gq) o[gq] += sl[gq * 192 + e] * vv; }
    }
    asm volatile("s_waitcnt lgkmcnt(0)" ::: "memory");
    if (lane < 4) { for (int e = 0; e < nnew; ++e) sl[lane * 192 + e] = 0.f; }
    asm volatile("s_waitcnt lgkmcnt(0)" ::: "memory");
#pragma unroll 1
    for (int e0 = 0; e0 < 144; e0 += 16) {
        float vv[16];
#pragma unroll
        for (int u = 0; u < 16; ++u) { int idx = 2048 + i - (e0 + u) * dil; idx = idx > 2047 ? 2047 : (idx < 0 ? 0 : idx); vv[u] = CV[(size_t)idx * 256 + lane]; }
#pragma unroll
        for (int u = 0; u < 16; ++u) {
            if (e0 + u <= 128) {
#pragma unroll
                for (int gq = 0; gq < 4; ++gq) o[gq] += sl[gq * 192 + e0 + u] * vv[u];
            }
        }
    }
#pragma unroll
    for (int gq = 0; gq < 4; ++gq) {
        float* pp = c.spart + ((size_t)((b * TS + i) * 16 + kvh * 4 + gq) * 3 + br) * 68;
        pp[4 + lane] = o[gq];
        if (lane == 0) { pp[0] = mx[gq]; pp[1] = lsum[gq]; }
    }
}
constexpr int N_PA = BP * 4 * 32 * 4, N_SA = BS * TS * 4 * 3, N_PA_A = 512;
__device__ __forceinline__ void p2a_mixers(const Ctx& c, unsigned char* lds, int G, int flags) {
    const int tid = threadIdx.x, lane = tid & 63, wave = tid >> 6;
    for (int bi = blockIdx.x; bi < 256; bi += G) { if (!(flags & 1)) ssd_a_item(c, bi, lds); }
    for (int sj = G - 1 - (int)blockIdx.x; sj < 128; sj += G) { if (!(flags & 4)) ssd_item<true>(c, sj >> 4, sj & 15, lds); }
    __syncthreads();
    float* sl = (float*)(lds + wave * 8192); float* wl = sl + 4 * 192;
    const float bnd = 64.f * QSCALE * wave_max(fabsf(c.q_norm_w[lane])) * wave_max(fabsf(c.k_norm_w[lane]));
    if (flags & 2) return;
    for (int it = blockIdx.x * NW + wave; it < N_PA_A + N_SA; it += G * NW) {
        if (it < N_PA_A) { if (!(flags & 128)) attn_prompt_mfma(c, (N_PA - N_PA_A) + it, lane, bnd, (bf16x8*)(lds + 65536 + wave * 8192) + lane, (bf16_t*)(lds + wave * 8192)); }
        else if (!(flags & 64)) attn_sample_wave(c, it - N_PA_A, lane, sl, wl);
    }
}
__device__ __forceinline__ void sample_tail(const Ctx& c, int bidx, int nb);
__device__ __forceinline__ void p2b_mixers(const Ctx& c, unsigned char* lds, int G, int flags) {
    const int tid = threadIdx.x, lane = tid & 63, wave = tid >> 6;
    const int nchain = G >= 128 ? 64 : 0;
    if (nchain) { if ((int)blockIdx.x < nchain) { if (!(flags & 8)) ssd_chain_item(c, blockIdx.x >> 4, blockIdx.x & 15, lds); return; } }
    else for (int bi = blockIdx.x; bi < 64; bi += G) ssd_chain_item(c, bi >> 4, bi & 15, lds);
    if (flags & 2) return;
    { const int tb = G - 1 - (int)blockIdx.x, ntb = (G - nchain) < 64 ? (G - nchain) : 64; if (tb < ntb) sample_tail(c, tb, ntb); }
    const float bnd = 64.f * QSCALE * wave_max(fabsf(c.q_norm_w[lane])) * wave_max(fabsf(c.k_norm_w[lane]));
    for (int it = ((int)blockIdx.x - nchain) * NW + wave; it < N_PA - N_PA_A; it += (G - nchain) * NW)
        attn_prompt_mfma(c, it, lane, bnd, (bf16x8*)(lds + 65536 + wave * 8192) + lane, (bf16_t*)(lds + wave * 8192));
}
__device__ __forceinline__ void sample_tail(const Ctx& c, int bidx, int nb) {
    const int tid = threadIdx.x, lane = tid & 63, wave = tid >> 6;
    for (int i = bidx * NT + tid; i < MS * DM / 4; i += nb * NT) ((f32x4*)(c.out + O_YS))[i] = ((const f32x4*)c.x_sample)[i];
    for (int it = bidx * NW + wave; it < MS * 16; it += nb * NW) {
        const float* pp = c.spart + (size_t)it * 3 * 68;
        const float m0 = pp[0], m1 = pp[68], m2 = pp[136]; const float mx = fmaxf(m0, fmaxf(m1, m2));
        const float w0 = __expf(m0 - mx), w1 = __expf(m1 - mx), w2 = __expf(m2 - mx);
        const float den = pp[1] * w0 + pp[69] * w1 + pp[137] * w2, num = pp[4 + lane] * w0 + pp[72 + lane] * w1 + pp[140 + lane] * w2;
        const int row = it >> 4, h = it & 15;
        const float gt = silu_f(c.sproj[(size_t)row * NCOL + C_G + h * 64 + lane]);
        c.ymix[(size_t)(MP + row) * DM + 1024 + h * 64 + lane] = f2bf(num / den * gt);
    }
}

struct EpiOut {
    static constexpr bool PERM = false, AFTER_DRAIN = true, RESCALE = true;
    const float* x; float* out;
    __device__ __forceinline__ void operator()(const f32x4 (&acc)[2][2][4][2], const pg8::Unit& u, int wr, int wc, int fr, int fq) const {}
    __device__ __forceinline__ void rescale(f32x4 (&acc)[2][2][4][2], int t, int wr, int fr, LAS unsigned char* lds) const {
        const LAS float* F = (const LAS float*)(lds + pg8::STAGE_BYTES) + (t == 8 ? 0 : 256);
#pragma unroll
        for (int ai = 0; ai < 2; ++ai)
#pragma unroll
            for (int m = 0; m < 4; ++m) { const float f = F[ai * 128 + wr * 64 + m * 16 + fr];
#pragma unroll
                for (int bj = 0; bj < 2; ++bj)
#pragma unroll
                    for (int n = 0; n < 2; ++n) acc[ai][bj][m][n] = acc[ai][bj][m][n] * f; }
    }
    __device__ __forceinline__ void fused(f32x4 (&acc)[2][2][4][2], const pg8::Unit& u, int wr, int wc, int fr, int fq, LAS unsigned char* lds, int wid, int lane) const {
        LAS float* T = (LAS float*)lds;
#pragma unroll
        for (int ai = 0; ai < 2; ++ai)
#pragma unroll
            for (int m = 0; m < 4; ++m) {
                __builtin_amdgcn_s_barrier();
                LAS float* tp = T + (16 * wr + fr) * 260 + 64 * wc + 16 * fq;
#pragma unroll
                for (int bj = 0; bj < 2; ++bj)
#pragma unroll
                    for (int n = 0; n < 2; ++n) *(LAS f32x4*)(tp + 8 * bj + 4 * n) = acc[ai][bj][m][n];
                asm volatile("s_waitcnt lgkmcnt(0)" ::: "memory"); __builtin_amdgcn_s_barrier(); asm volatile("" ::: "memory");
#pragma unroll
                for (int k = 0; k < 4; ++k) {
                    const int tr = wid + 8 * k;
                    const size_t grow = (size_t)u.pm * 256 + ai * 128 + (tr >> 4) * 64 + m * 16 + (tr & 15);
                    const f32x4 v = *(LAS f32x4*)(T + tr * 260 + 4 * lane);
                    const size_t off = grow * DM + (size_t)u.pn * 256 + 4 * lane;
                    __builtin_nontemporal_store(__builtin_nontemporal_load((const f32x4*)(x + off)) + v, (f32x4*)(out + off));
                }
            }
    }
};
__device__ __forceinline__ void p3_sample(const Ctx& c, int G) {
    const int tid = threadIdx.x, lane = tid & 63, wave = tid >> 6, fr = lane & 15, fq = lane >> 4;
    for (int un = blockIdx.x * NW + wave; un < (DM / 16) * 16; un += G * NW) {
        const int nt = un & 127, ks = un >> 7;
        f32x4 acc[2] = {{0.f, 0.f, 0.f, 0.f}, {0.f, 0.f, 0.f, 0.f}};
        skinny_unit(c.ymix + (size_t)MP * DM, c.wt_out + (size_t)nt * 16 * DM, ks * 128, ks * 128 + 128, acc, fr, fq);
        const int lc = logical_of_phys_row(nt * 16 + fr);
#pragma unroll
        for (int mt = 0; mt < 2; ++mt)
#pragma unroll
            for (int r = 0; r < 4; ++r) {
                const int row = 16 * mt + 4 * fq + r; float f = 1.f;
                if (ks < 8) { const float* q = c.ssq + (size_t)(MP + row) * 16 + 8 * (ks >> 2); f = rsqrtf((((q[0] + q[1]) + (q[2] + q[3])) + ((q[4] + q[5]) + (q[6] + q[7]))) * (1.f / 512.f) + EPS); }
                atomicAdd(c.out + O_YS + (size_t)row * DM + lc, acc[mt][r] * f);
            }
    }
}

#define XB_TMO      128
#define XB_XCNT(j)  (256  + 64 * (j))
#define XB_XSUB(j)  (1280 + 64 * (j))
#define XB_XGEN(j)  (2304 + 64 * (j))
#define XB_TOP      3328
#define XB_TOPGEN   3392
#define XCD_BAR_WORDS 3456
#define XB_SPIN_CAP (1u << 18)

__device__ __forceinline__ unsigned xb_ld(unsigned* p)              { return __hip_atomic_load(p, __ATOMIC_RELAXED, __HIP_MEMORY_SCOPE_AGENT); }
__device__ __forceinline__ unsigned xb_add(unsigned* p, unsigned v) { return __hip_atomic_fetch_add(p, v, __ATOMIC_RELAXED, __HIP_MEMORY_SCOPE_AGENT); }
__device__ __forceinline__ unsigned xb_xcc_id() { return (unsigned)__builtin_amdgcn_s_getreg((3 << 11) | 20) & 0xFu; }
#define XB_SPIN(cond, bar) do { unsigned _sp = 0; while (cond) { __builtin_amdgcn_s_sleep(1); \
    if ((++_sp & 255u) == 0u) { if (xb_ld(&(bar)[XB_TMO])) break; if (_sp > XB_SPIN_CAP) { atomicAdd(&(bar)[XB_TMO], 1u); break; } } } } while (0)

struct XcdBarrier {
    unsigned* bar; unsigned x;
    volatile LAS unsigned* st;
};

__device__ __forceinline__ XcdBarrier xcd_barrier_post(unsigned* bar, volatile LAS unsigned* st) {
    XcdBarrier b; b.bar = bar; b.x = xb_xcc_id(); b.st = st;
    if (threadIdx.x == 0) (void)xb_add(&bar[XB_XCNT(b.x)], 1u);
    return b;
}
__device__ __forceinline__ void xcd_barrier_complete(unsigned* bar, unsigned x, unsigned& nloc, unsigned& nx) {
    const unsigned G = gridDim.x * gridDim.y * gridDim.z;
    unsigned sum, cnt, mine, sp = 0u;
    for (;;) {
        sum = 0u; cnt = 0u; mine = 0u;
#pragma unroll
        for (unsigned j = 0; j < 16; ++j) { const unsigned c = xb_ld(&bar[XB_XCNT(j)]); sum += c; cnt += (c > 0u) ? 1u : 0u; mine = (j == x) ? c : mine; }
        if (sum == G) break;
        __builtin_amdgcn_s_sleep(1);
        if ((++sp & 255u) == 0u) { if (xb_ld(&bar[XB_TMO])) break; if (sp > XB_SPIN_CAP) { atomicAdd(&bar[XB_TMO], 1u); break; } }
    }
    nloc = mine > 0u ? mine : 1u; nx = cnt > 0u ? cnt : 1u;
}

__device__ __forceinline__ void xcd_barrier(const XcdBarrier& b) {
    asm volatile("s_waitcnt vmcnt(0)" ::: "memory");
    __syncthreads();
    if (threadIdx.x == 0) {
        unsigned* bar = b.bar;
        __builtin_amdgcn_s_waitcnt(0);
        unsigned nloc = b.st[0], nx = b.st[1];
        if (nloc == 0u) { xcd_barrier_complete(bar, b.x, nloc, nx); b.st[0] = nloc; b.st[1] = nx; }
        const unsigned old = xb_add(&bar[XB_XSUB(b.x)], 1u);
        const unsigned gen = old / nloc;
        if (old + 1u == (gen + 1u) * nloc) {
            __builtin_amdgcn_fence(__ATOMIC_RELEASE, "agent");
            asm volatile("s_waitcnt vmcnt(0)" ::: "memory");
            const unsigned og = xb_add(&bar[XB_TOP], 1u);
            const unsigned tg = og / nx;
            if (og + 1u == (tg + 1u) * nx) xb_add(&bar[XB_TOPGEN], 1u);
            else XB_SPIN(xb_ld(&bar[XB_TOPGEN]) == tg, bar);
            __builtin_amdgcn_fence(__ATOMIC_ACQUIRE, "agent");
            xb_add(&bar[XB_XGEN(b.x)], 1u);
            asm volatile("s_waitcnt vmcnt(0)" ::: "memory");
        } else {
            XB_SPIN(xb_ld(&bar[XB_XGEN(b.x)]) == gen, bar);
            __builtin_amdgcn_fence(__ATOMIC_ACQUIRE, "agent");
            asm volatile("s_waitcnt vmcnt(0)" ::: "memory");
        }
    }
    __syncthreads();
}

struct Args { const float* in[17]; float* out; unsigned char* ws; int ph_lo, ph_hi, flags, pad; };
__global__ void __launch_bounds__(NT, 2) fwd_kernel(Args a) {
    extern __shared__ __attribute__((aligned(16))) unsigned char lds[];
    Ctx c;
    c.x_prompt = a.in[0]; c.x_sample = a.in[1]; c.cache_k = a.in[2]; c.cache_v = a.in[3]; c.state_conv = a.in[4]; c.state_ssm = a.in[5]; c.norm_w = a.in[6]; c.w_in = a.in[7];
    c.conv_w = a.in[8]; c.conv_b = a.in[9]; c.dt_bias = a.in[10]; c.a_log = a.in[11]; c.d_skip = a.in[12]; c.ssd_norm_w = a.in[13]; c.q_norm_w = a.in[14]; c.k_norm_w = a.in[15]; c.w_out = a.in[16];
    c.out = a.out; unsigned char* ws = a.ws;
    c.ctl = (unsigned*)(ws + WS_CTL); c.wt_in = (bf16_t*)(ws + WS_WTIN); c.wt_out = (bf16_t*)(ws + WS_WTOUT); c.xn = (bf16_t*)(ws + WS_XN); c.proj = (bf16_t*)(ws + WS_PROJ);
    c.dt = (float*)(ws + WS_DT); c.sproj = (float*)(ws + WS_SPROJ); c.rope = (float*)(ws + WS_ROPE); c.ymix = (bf16_t*)(ws + WS_YMIX); c.ssq = (float*)(ws + WS_SSQ); c.vt1 = (bf16_t*)(ws + WS_VT1); c.vt4 = (bf16_t*)(ws + WS_VT4); c.vt16 = (bf16_t*)(ws + WS_VT16); c.spart = (float*)(ws + WS_SPART); c.st = (float*)(ws + WS_ST); c.el = (float*)(ws + WS_EL); c.cd = (float*)(ws + WS_CD); c.yd = (float*)(ws + WS_YD); c.xcc = (bf16_t*)(ws + WS_XCC);
    const int G = gridDim.x;
    const int lo = a.ph_lo, hi = a.ph_hi;
    volatile LAS unsigned* bst = (volatile LAS unsigned*)((LAS unsigned char*)lds + (LDS_BYTES - 64));
    if (threadIdx.x == 0) { bst[0] = 0u; bst[1] = 0u; }
    __syncthreads();
    const XcdBarrier bar = xcd_barrier_post((unsigned*)(ws + WS_BAR), bst);
    if (lo < 0) cg::this_grid().sync();
#ifndef PH_MASK
#define PH_MASK 31
#endif
#define IN(k) (((PH_MASK >> (k)) & 1) && lo <= (k) && (k) < hi)
#define SEAM(k) do { if (IN(k) && IN((k) + 1)) xcd_barrier(bar); } while (0)
    if (IN(0)) p0_prologue(c, lds, G);
    SEAM(0);
    if (IN(1)) {
        pg8::Gemm g{c.xn, c.wt_in, MP, NBIG, DM}; pg8::StaticOrder S; S.init(MP, NBIG, G, (int)blockIdx.x);
        EpiIn E{c.proj, c.out, c.rope, c.q_norm_w, c.k_norm_w, c.vt1, c.vt4, c.vt16};
        pg8::gemm_phase<EpiIn, pg8::StaticOrder, true, true>((LAS unsigned char*)lds, g, S, E);
        const int half = G / 2;
        if ((int)blockIdx.x >= half) p1_extras(c, (int)blockIdx.x - half, G - half);
    }
    SEAM(1);
    if (IN(2)) p2a_mixers(c, lds, G, a.flags);
    SEAM(2);
    if (IN(3)) p2b_mixers(c, lds, G, a.flags);
    SEAM(3);
    if (IN(4)) {
        pg8::Gemm g{c.ymix, c.wt_out, MP, DM, DM}; pg8::StaticOrder S; S.init(MP, DM, G, (int)blockIdx.x);
        EpiOut E{c.x_prompt, c.out + O_YP};
        {
            pg8::Unit u0;
            if (S.next(0, u0)) {
                float* F = (float*)(lds + pg8::STAGE_BYTES);
                for (int rI = threadIdx.x; rI < 256; rI += NT) {
                    const float* q = c.ssq + (size_t)(u0.pm * 256 + rI) * 16;
                    const f32x4 a0 = *(const f32x4*)q, a1 = *(const f32x4*)(q + 4), b0 = *(const f32x4*)(q + 8), b1 = *(const f32x4*)(q + 12);
                    const float s0 = ((a0.x + a0.y) + (a0.z + a0.w)) + ((a1.x + a1.y) + (a1.z + a1.w)), s1 = ((b0.x + b0.y) + (b0.z + b0.w)) + ((b1.x + b1.y) + (b1.z + b1.w));
                    const float r0 = rsqrtf(s0 * (1.f / 512.f) + EPS), r1 = rsqrtf(s1 * (1.f / 512.f) + EPS);
                    F[rI] = r0 / r1; F[256 + rI] = r1;
                }
            }
            __syncthreads();
        }
        pg8::gemm_phase<EpiOut, pg8::StaticOrder, false, true>((LAS unsigned char*)lds, g, S, E);
        if (!(a.flags & 32)) p3_sample(c, G);
    }
}

extern "C" void kernel_launch(void* const* d_in, const int* in_sizes, int n_in, void* d_out, int out_size, void* d_ws, size_t ws_size, hipStream_t stream) {
    static int grid = 0;
    if (grid == 0) {
        if (n_in != 17 || (size_t)out_size != O_END || ws_size < WS_END) { fprintf(stderr, "kernel_launch: unexpected sizes n_in %d out %d ws %zu\n", n_in, out_size, ws_size); grid = -1; return; }
        int dev = 0, cus = 0, per_cu = 0;
        hipGetDevice(&dev); hipDeviceGetAttribute(&cus, hipDeviceAttributeMultiprocessorCount, dev);
        hipFuncSetAttribute((const void*)fwd_kernel, hipFuncAttributeMaxDynamicSharedMemorySize, LDS_BYTES);
        hipOccupancyMaxActiveBlocksPerMultiprocessor(&per_cu, (const void*)fwd_kernel, NT, LDS_BYTES);
        (void)hipGetLastError();
        if (per_cu < 1) { fprintf(stderr, "kernel_launch: occupancy query says %d blocks per CU\n", per_cu); per_cu = 1; }
        grid = cus;
    }
    if (grid < 0) return;
    hipMemsetAsync((char*)d_ws + WS_CTL, 0, WS_CTL_BYTES, stream);
    Args a{};
    for (int i = 0; i < 17; ++i) a.in[i] = (const float*)d_in[i];
    a.out = (float*)d_out; a.ws = (unsigned char*)d_ws;
#if N_LAUNCHES == 1
    a.ph_lo = 0; a.ph_hi = 5;
    void* args[] = {&a};
    hipError_t e = hipLaunchCooperativeKernel((const void*)fwd_kernel, dim3(grid), dim3(NT), args, LDS_BYTES, stream);
    if (e != hipSuccess) fprintf(stderr, "cooperative launch failed: %s (grid %d)\n", hipGetErrorString(e), grid);
#else
#ifndef PROBE_REP
#define PROBE_REP -1
#endif
#ifndef PROBE_FLAGS
#define PROBE_FLAGS 0
#endif
    for (int ph = 0; ph < 5; ++ph) {
        for (int rp = 0; rp < (ph == PROBE_REP ? 2 : 1); ++rp) {
            if (rp) hipMemsetAsync((char*)d_ws + WS_CTL, 0, WS_CTL_BYTES, stream);
            a.ph_lo = ph; a.ph_hi = ph + 1; a.flags = (ph == PROBE_REP && rp == 0) ? PROBE_FLAGS : 0;
            hipLaunchKernelGGL(fwd_kernel, dim3(grid), dim3(NT), LDS_BYTES, stream, a);
        }
    }
#endif
}
```
